# Optimizing an MI355X kernel written in HIP

```python
import math
import jax, jax.numpy as jnp
from jax import lax
import numpy as np

D_MODEL = 1024
BATCH = 8
SEQ = 4096
DEPTH = 4

HEAD_DIM = 64
ATTN_WIDTH = 3 * D_MODEL // 4
ATTN_HEADS = ATTN_WIDTH // HEAD_DIM
DILATED_GROUPS = ((128, 1), (512, 4), (2048, 16))
HEADS_PER_GROUP = ATTN_HEADS // len(DILATED_GROUPS)
ATTN_BLOCK = 128
ROT_DIM = HEAD_DIM // 4
ROPE_THETA = 500000.0
CONV_WIDTH = D_MODEL // 2
CONV_K = 3
SG_WIDTH = D_MODEL // 2
SG_CHUNK = 128
SG_GROUPS = 4
SG_GROUP_CH = SG_WIDTH // SG_GROUPS
N_BRANCH = 3
D_FF = 4 * D_MODEL
PLE_DIM = 256
RMS_EPS = 1e-6
LN_EPS = 1e-5
IN_WIDTH = 3 * ATTN_WIDTH + 3 * CONV_WIDTH + 2 * SG_WIDTH + N_BRANCH * D_MODEL

kernel_name = 'hybrid_gated_dilated_conv_sgu_trunk'


def rms_norm(x, g):
    xf = x.astype(jnp.float32)
    y = xf * lax.rsqrt(jnp.mean(xf * xf, axis=-1, keepdims=True) + RMS_EPS)
    return (y * g.astype(jnp.float32)).astype(x.dtype)


def layer_norm(x, g, b):
    xf = x.astype(jnp.float32)
    mu = jnp.mean(xf, axis=-1, keepdims=True)
    xc = xf - mu
    y = xc * lax.rsqrt(jnp.mean(xc * xc, axis=-1, keepdims=True) + LN_EPS)
    return (y * g.astype(jnp.float32) + b.astype(jnp.float32)).astype(x.dtype)


def rotary_partial(t, cos, sin):
    half = ROT_DIM // 2
    x1 = t[..., :half]
    x2 = t[..., half:ROT_DIM]
    rot = jnp.concatenate([x1 * cos - x2 * sin, x2 * cos + x1 * sin], axis=-1)
    return jnp.concatenate([rot, t[..., ROT_DIM:]], axis=-1)


def dilated_causal_attention(q, k, v, window, dilation):
    bsz, S, H, E = q.shape
    span = window // dilation
    assert span <= ATTN_BLOCK
    unit = dilation * ATTN_BLOCK
    L = -(-S // unit) * unit
    M = L // dilation
    NB = M // ATTN_BLOCK

    def to_blocks(t):
        t = jnp.pad(t, ((0, 0), (0, L - S), (0, 0), (0, 0)))
        t = t.reshape(bsz, M, dilation, H, E).transpose(0, 2, 3, 1, 4)
        return t.reshape(bsz, dilation, H, NB, ATTN_BLOCK, E)

    def with_prev(t):
        prev = jnp.pad(t, ((0, 0), (0, 0), (0, 0), (1, 0), (0, 0), (0, 0)))[:, :, :, :-1]
        return jnp.concatenate([prev, t], axis=-2)

    qb = to_blocks(q)
    kw = with_prev(to_blocks(k))
    vw = with_prev(to_blocks(v))
    s = jnp.einsum('brhnqe,brhnke->brhnqk', qb, kw).astype(jnp.float32) * (HEAD_DIM ** -0.5)
    qi = jnp.arange(ATTN_BLOCK)[:, None]
    kj = jnp.arange(2 * ATTN_BLOCK)[None, :]
    dist = qi + ATTN_BLOCK - kj
    band = (dist >= 0) & (dist <= span)
    blk = jnp.arange(NB)[:, None, None]
    mask = band[None] & (blk * ATTN_BLOCK + kj[None] - ATTN_BLOCK >= 0)
    s = jnp.where(mask, s, -jnp.inf)
    lse = jax.nn.logsumexp(s, axis=-1)
    probs = jnp.exp(s - lse[..., None])
    o = jnp.einsum('brhnqk,brhnke->brhnqe', probs.astype(v.dtype), vw)
    o = o.reshape(bsz, dilation, H, M, E).transpose(0, 3, 1, 2, 4).reshape(bsz, L, H, E)[:, :S]
    lse = lse.reshape(bsz, dilation, H, M).transpose(0, 3, 1, 2).reshape(bsz, L, H)[:, :S]
    return o, lse


def dilated_mixture(q, k, v):
    outs, lses = [], []
    for g, (window, dilation) in enumerate(DILATED_GROUPS):
        sl = slice(g * HEADS_PER_GROUP, (g + 1) * HEADS_PER_GROUP)
        o, l = dilated_causal_attention(q[:, :, sl], k[:, :, sl], v[:, :, sl], window, dilation)
        outs.append(o)
        lses.append(l)
    alpha = jax.nn.softmax(jnp.stack(lses, axis=0), axis=0)
    ya = jnp.concatenate([o * alpha[g][..., None].astype(o.dtype) for g, o in enumerate(outs)], axis=2)
    bsz, S = q.shape[0], q.shape[1]
    return ya.reshape(bsz, S, ATTN_WIDTH)


def short_conv(z, w):
    C = z.shape[-1]
    return lax.conv_general_dilated(z, w[:, None, :].astype(z.dtype), window_strides=(1,),
                                    padding=[(CONV_K - 1, 0)],
                                    dimension_numbers=('NWC', 'WIO', 'NWC'),
                                    feature_group_count=C)


def spatial_gating(zs, ln_g, ln_b, w_s, b_s):
    bsz, S, _ = zs.shape
    zs = jax.nn.gelu(zs, approximate=False)
    u, v = zs[..., :SG_WIDTH], zs[..., SG_WIDTH:]
    v = layer_norm(v, ln_g, ln_b)
    v = v.reshape(bsz, S // SG_CHUNK, SG_CHUNK, SG_GROUPS, SG_GROUP_CH)
    causal = jnp.tril(jnp.ones((SG_CHUNK, SG_CHUNK), dtype=bool))
    w = jnp.where(causal[None], w_s, jnp.zeros_like(w_s))
    sv = jnp.einsum('gts,bnsgc->bntgc', w, v) + b_s.T[None, None, :, :, None]
    return u * sv.reshape(bsz, S, SG_WIDTH)


def setup_inputs(seed: int = 0) -> dict:
    key = jax.random.key(seed)
    ks = jax.random.split(key, 24)

    def nrm(k, shape, scale):
        return jax.random.normal(k, shape, dtype=jnp.float32) * scale

    def gain(k, shape):
        return 1.0 + 0.05 * jax.random.normal(k, shape, dtype=jnp.float32)

    x = nrm(ks[0], (BATCH, SEQ, D_MODEL), 1.0)
    p = nrm(ks[1], (DEPTH, BATCH, SEQ, PLE_DIM), 1.0)
    offsets = jax.random.randint(ks[2], (BATCH, 1), 0, 1024, dtype=jnp.int32)
    positions = offsets + jnp.arange(SEQ, dtype=jnp.int32)[None, :]
    return {
        'x': x,
        'p': p,
        'positions': positions,
        'norm_mix_g': gain(ks[3], (DEPTH, D_MODEL)),
        'w_in': nrm(ks[4], (DEPTH, D_MODEL, IN_WIDTH), D_MODEL ** -0.5),
        'conv_w': nrm(ks[5], (DEPTH, CONV_K, CONV_WIDTH), CONV_K ** -0.5),
        'sg_ln_g': gain(ks[6], (DEPTH, SG_WIDTH)),
        'sg_ln_b': nrm(ks[7], (DEPTH, SG_WIDTH), 0.02),
        'sg_w': nrm(ks[8], (DEPTH, SG_GROUPS, SG_CHUNK, SG_CHUNK), SG_CHUNK ** -0.5),
        'sg_b': gain(ks[9], (DEPTH, SG_GROUPS, SG_CHUNK)),
        'w_branch_a': nrm(ks[10], (DEPTH, ATTN_WIDTH, D_MODEL), ATTN_WIDTH ** -0.5),
        'w_branch_b': nrm(ks[11], (DEPTH, CONV_WIDTH, D_MODEL), CONV_WIDTH ** -0.5),
        'w_branch_c': nrm(ks[12], (DEPTH, SG_WIDTH, D_MODEL), SG_WIDTH ** -0.5),
        'w_out': nrm(ks[13], (DEPTH, D_MODEL, D_MODEL), 0.5 * D_MODEL ** -0.5),
        'norm_mlp_g': gain(ks[14], (DEPTH, D_MODEL)),
        'w_up': nrm(ks[15], (DEPTH, D_MODEL, D_FF), D_MODEL ** -0.5),
        'w_down': nrm(ks[16], (DEPTH, D_FF, D_MODEL), 0.5 * D_FF ** -0.5),
        'norm_ple_g': gain(ks[17], (DEPTH, D_MODEL)),
        'w_ple_gate': nrm(ks[18], (DEPTH, D_MODEL, D_MODEL), D_MODEL ** -0.5),
        'w_ple_proj': nrm(ks[19], (DEPTH, PLE_DIM, D_MODEL), 0.5 * PLE_DIM ** -0.5),
        'norm_final_g': gain(ks[20], (D_MODEL,)),
    }


def reference(x, p, positions, norm_mix_g, w_in, conv_w, sg_ln_g, sg_ln_b, sg_w, sg_b,
              w_branch_a, w_branch_b, w_branch_c, w_out, norm_mlp_g, w_up, w_down,
              norm_ple_g, w_ple_gate, w_ple_proj, norm_final_g):
    bsz, S, _ = x.shape
    inv_freq = ROPE_THETA ** (-(jnp.arange(0, ROT_DIM, 2, dtype=jnp.float32) / ROT_DIM))
    ang = positions.astype(jnp.float32)[..., None] * inv_freq
    cos = jnp.cos(ang)[:, :, None, :].astype(x.dtype)
    sin = jnp.sin(ang)[:, :, None, :].astype(x.dtype)
    widths = [ATTN_WIDTH, ATTN_WIDTH, ATTN_WIDTH, CONV_WIDTH, CONV_WIDTH, CONV_WIDTH, 2 * SG_WIDTH]
    splits = [int(c) for c in np.cumsum(widths)]
    h = x
    for i in range(DEPTH):
        a = rms_norm(h, norm_mix_g[i])
        z = a @ w_in[i]
        zq, zk, zv, zx, zb, zc, zs, zg = jnp.split(z, splits, axis=-1)
        q = rotary_partial(zq.reshape(bsz, S, ATTN_HEADS, HEAD_DIM), cos, sin)
        k = rotary_partial(zk.reshape(bsz, S, ATTN_HEADS, HEAD_DIM), cos, sin)
        v = zv.reshape(bsz, S, ATTN_HEADS, HEAD_DIM)
        ya = dilated_mixture(q, k, v)
        yb = zb * short_conv(zc * zx, conv_w[i])
        yc = spatial_gating(zs, sg_ln_g[i], sg_ln_b[i], sg_w[i], sg_b[i])
        gates = jax.nn.sigmoid(zg.reshape(bsz, S, N_BRANCH, D_MODEL))
        m = (gates[:, :, 0] * (ya @ w_branch_a[i])
             + gates[:, :, 1] * (yb @ w_branch_b[i])
             + gates[:, :, 2] * (yc @ w_branch_c[i]))
        h = h + m @ w_out[i]
        c = rms_norm(h, norm_mlp_g[i])
        h = h + jnp.square(jax.nn.relu(c @ w_up[i])) @ w_down[i]
        e = rms_norm(h, norm_ple_g[i])
        h = h + jax.nn.sigmoid(e @ w_ple_gate[i]) * (p[i] @ w_ple_proj[i])
    return rms_norm(h, norm_final_g)
```

```cpp
#include <hip/hip_runtime.h>
#include <hip/hip_cooperative_groups.h>
#include <cstdio>
#include <cstdint>
#include <cmath>
namespace cg = cooperative_groups;
#ifndef PROBE_ATTN
#define PROBE_ATTN 0
#endif
#ifndef PROBE_MIX
#define PROBE_MIX 0
#endif
#ifndef PROBE_CVT
#define PROBE_CVT 0
#endif
#ifndef PROBE_IN
#define PROBE_IN 0
#endif
#ifndef PROBE_UP
#define PROBE_UP 0
#endif
#ifndef PROBE_GATE
#define PROBE_GATE 0
#endif
#ifndef PROBE_RESMIX
#define PROBE_RESMIX 0
#endif
#ifndef PROBE_DOWN
#define PROBE_DOWN 0
#endif
#ifndef PROBE_PLE
#define PROBE_PLE 0
#endif
#ifndef PROBE_INDRY
#define PROBE_INDRY 0
#endif
#ifndef PROBE_SYNC
#define PROBE_SYNC 0
#endif
#ifndef MK_PER_PHASE_LAUNCH
#define MK_PER_PHASE_LAUNCH 0
#endif
__device__ __forceinline__ int lane_id_opaque();
namespace pg8 {
#define PG8_LAS __attribute__((address_space(3)))
typedef unsigned short bf16_t;
typedef short bf16x8 __attribute__((ext_vector_type(8)));
typedef float f32x4 __attribute__((ext_vector_type(4)));
typedef unsigned u32x4 __attribute__((ext_vector_type(4)));
constexpr int BM = 256, BK = 64, HALF = 128, HTB = HALF * BK * 2  , STAGE_BYTES = 8 * HTB, NXCD = 8, WGM = 4;

__host__ __device__ __forceinline__ int lds_byte(int r, int c) { const int st = (r >> 4) * 2 + (c >> 5), rr = r & 15, cc = c & 31, ob = rr * 64 + cc * 2; return st * 1024 + (ob ^ (((ob >> 9) & 1) << 5)); }
__host__ __device__ __forceinline__ void stage_rc(int b, int& R, int& C) { const int st = b / 1024, sb = b % 1024, swz = sb ^ (((sb >> 9) & 1) << 5); R = (st >> 1) * 16 + swz / 64; C = (st & 1) * 32 + (swz % 64) / 2; }
__host__ __device__ __forceinline__ int perm32(int rho) { const int n = rho >> 4, i = rho & 15; return 8 * (i >> 2) + 4 * n + (i & 3); }

struct Unit { int pm, pn; };
struct Gemm { const bf16_t* A; int lda; const bf16_t* Bt; int ldb; int M, N, K, wave; };

struct StaticOrder {
    int nM, nN, nwg, G, c;
    __host__ __device__ void init(int M, int N, int G_, int c_) { nM = M / BM; nN = N / BM; nwg = nM * nN; G = G_; c = c_; }
    __host__ __device__ bool next(int i, Unit& u) const {
        const long L = (long)i * G + c; if (L >= nwg) return false;
        int wgid = (int)L; { const int q = nwg / NXCD, r = nwg % NXCD, xcd = wgid % NXCD, off = wgid / NXCD; wgid = (xcd < r ? xcd * (q + 1) : r * (q + 1) + (xcd - r) * q) + off; }
        const int nig = WGM * nN, gid = wgid / nig, fm = gid * WGM, gsz = (nM - fm) < WGM ? (nM - fm) : WGM;
        u.pm = fm + ((wgid % nig) % gsz); u.pn = (wgid % nig) / gsz; return true;
    }
    __device__ __forceinline__ void a_ready(const Unit&) const {}
    __device__ __forceinline__ void done(const Unit&) const {}
};

__device__ __forceinline__ unsigned cvt_pk_bf16(float lo, float hi) { unsigned r; asm volatile("v_cvt_pk_bf16_f32 %0, %1, %2" : "=v"(r) : "v"(lo), "v"(hi)); return r; }
typedef float f32x2 __attribute__((ext_vector_type(2)));
__device__ __forceinline__ f32x2 gelu_pk(f32x2 v) {
    const f32x2 av = __builtin_elementwise_abs(v), d = av * 0.2316418882f + 1.0f;
    f32x2 t; t.x = __builtin_amdgcn_rcpf(d.x); t.y = __builtin_amdgcn_rcpf(d.y);
    f32x2 q = t * 0.5307027145f + (-0.7265760135f); q = q * t + 0.7107068705f; q = q * t + (-0.142248368f); q = q * t + 0.127414796f; q = q * t;
    const f32x2 s = (v * v) * (-0.72134752044f);
    f32x2 e; e.x = __builtin_amdgcn_exp2f(s.x); e.y = __builtin_amdgcn_exp2f(s.y);
    const f32x2 m = v * (q * e), r = v - m;
    f32x2 o; o.x = v.x < 0.f ? m.x : r.x; o.y = v.y < 0.f ? m.y : r.y; return o;
}
template <class Epi, class Sched, bool ALIGN_EPI = false, bool SP2 = false>
__device__ __forceinline__ void gemm_phase(PG8_LAS unsigned char* lds, const Gemm g, const Sched& S, const Epi& E) {
    const int tid = g.wave * 64 + lane_id_opaque(),
        wid = __builtin_amdgcn_readfirstlane(tid >> 6), lane = tid & 63, wr = wid >> 2, wc = wid & 3, fr = lane & 15, fq = lane >> 4;
    const int K = g.K, nt = K / BK;
    unsigned voffA[2], voffB[2];
#pragma unroll
    for (int i = 0; i < 2; ++i) { int R, C; stage_rc(tid * 16 + i * 8192, R, C); const int Rb = Epi::PERM ? ((R & ~31) + perm32(R & 31)) : R;
        voffA[i] = (unsigned)(R * g.lda + C) * 2u; voffB[i] = (unsigned)(Rb * g.ldb + C) * 2u; }
    const size_t kstep = (size_t)(BK * 2);
    const size_t hstepA = (size_t)HALF * g.lda * 2, hstepB = (size_t)HALF * g.ldb * 2;
    const size_t tstepA = 2 * hstepA, tstepB = 2 * hstepB;
    const unsigned ldsw = (unsigned)wid * 1024u;
    const int aoff = lds_byte(wr * 64 + fr, fq * 8), boff = lds_byte(wc * 32 + fr, fq * 8);
#define PG8_SA(b, h) (((b) * 2 + (h)) * HTB)
#define PG8_SB(b, h) ((4 + (b) * 2 + (h)) * HTB)
#define PG8_STAGE(bufoff, gbase, voff) do { _Pragma("unroll") for (int _i = 0; _i < 2; ++_i) \
        __builtin_amdgcn_global_load_lds((const unsigned*)((const char*)(gbase) + (voff)[_i]), (PG8_LAS unsigned*)(lds + (bufoff) + ldsw + _i * 8192), 16, 0, 0); } while (0)
#define PG8_LDA(dst, b, h) do { _Pragma("unroll") for (int m = 0; m < 4; ++m) _Pragma("unroll") for (int k = 0; k < 2; ++k) dst[m][k] = *(const PG8_LAS bf16x8*)(lds + PG8_SA(b, h) + aoff + m * 2048 + k * 1024); } while (0)
#define PG8_LDB(dst, b, h) do { _Pragma("unroll") for (int n = 0; n < 2; ++n) _Pragma("unroll") for (int k = 0; k < 2; ++k) dst[n][k] = *(const PG8_LAS bf16x8*)(lds + PG8_SB(b, h) + boff + n * 2048 + k * 1024); } while (0)
#define PG8_MMA(ai, bj, At, Bt) do { __builtin_amdgcn_s_setprio(1); _Pragma("unroll") for (int m = 0; m < 4; ++m) _Pragma("unroll") for (int n = 0; n < 2; ++n) _Pragma("unroll") for (int k = 0; k < 2; ++k) \
        acc[ai][bj][m][n] = __builtin_amdgcn_mfma_f32_16x16x32_bf16(Bt[n][k], At[m][k], acc[ai][bj][m][n], 0, 0, 0); __builtin_amdgcn_s_setprio(0); } while (0)
#define PG8_WAIT_V(n) asm volatile("s_waitcnt vmcnt(" #n ")" ::: "memory")
#define PG8_WAIT_L(n) asm volatile("s_waitcnt lgkmcnt(" #n ")" ::: "memory")
#define PG8_BAR __builtin_amdgcn_s_barrier()
#define PG8_SCHED __builtin_amdgcn_sched_barrier(0)
    Unit cur, nxt; int ui = 0;
    if (!S.next(0, cur)) return;
    f32x4 acc[2][2][4][2];
#pragma unroll
    for (int a = 0; a < 2; ++a)
#pragma unroll
        for (int b = 0; b < 2; ++b)
#pragma unroll
            for (int m = 0; m < 4; ++m)
#pragma unroll
                for (int n = 0; n < 2; ++n) acc[a][b][m][n] = (f32x4){0.f, 0.f, 0.f, 0.f};
    bf16x8 At[4][2], B0[2][2], B1[2][2];
    const char* cA = (const char*)g.A + (size_t)cur.pm * tstepA; const char* cB = (const char*)g.Bt + (size_t)cur.pn * tstepB;
    S.a_ready(cur);
    if constexpr (SP2) {
        PG8_STAGE(PG8_SB(0, 0), cB, voffB); PG8_STAGE(PG8_SB(0, 1), cB + hstepB, voffB); PG8_STAGE(PG8_SA(0, 0), cA, voffA); PG8_STAGE(PG8_SA(0, 1), cA + hstepA, voffA);
        if (wr == 1) PG8_BAR;
        PG8_WAIT_V(2); PG8_BAR;
        PG8_STAGE(PG8_SB(1, 0), cB + kstep, voffB); PG8_STAGE(PG8_SA(1, 0), cA + kstep, voffA); PG8_STAGE(PG8_SB(1, 1), cB + hstepB + kstep, voffB);
        PG8_WAIT_V(6); PG8_BAR;
    } else {
        PG8_STAGE(PG8_SB(0, 0), cB, voffB); PG8_STAGE(PG8_SA(0, 0), cA, voffA); PG8_STAGE(PG8_SB(0, 1), cB + hstepB, voffB); PG8_STAGE(PG8_SA(0, 1), cA + hstepA, voffA);
        if (wr == 1) PG8_BAR;
        PG8_WAIT_V(4); PG8_BAR;
        PG8_STAGE(PG8_SB(1, 0), cB + kstep, voffB); PG8_STAGE(PG8_SA(1, 0), cA + kstep, voffA); PG8_STAGE(PG8_SB(1, 1), cB + hstepB + kstep, voffB);
        PG8_WAIT_V(6); PG8_BAR;
    }
    for (;;) {
        const bool has_next = S.next(ui + 1, nxt);
        const char* nA = has_next ? (const char*)g.A + (size_t)nxt.pm * tstepA : cA; const char* nB = has_next ? (const char*)g.Bt + (size_t)nxt.pn * tstepB : cB;
        for (int t = 0; t < nt; t += 2) {
            const bool last = (t == nt - 2);
            const char* a1 = cA + (size_t)(t + 1) * kstep;
            const char* a2 = last ? nA : cA + (size_t)(t + 2) * kstep; const char* b2 = last ? nB : cB + (size_t)(t + 2) * kstep;
            const char* a3 = a2 + kstep; const char* b3 = b2 + kstep;
            if (last && has_next) S.a_ready(nxt);
            if constexpr (SP2) {
            PG8_LDB(B0, 0, 0); PG8_LDB(B1, 0, 1); PG8_SCHED; PG8_LDA(At, 0, 0); PG8_STAGE(PG8_SA(1, 1), a1 + hstepA, voffA);
            PG8_WAIT_V(8); PG8_WAIT_L(0); PG8_BAR; PG8_MMA(0, 0, At, B0); PG8_MMA(0, 1, At, B1); PG8_BAR; PG8_SCHED;
            PG8_LDA(At, 0, 1); PG8_STAGE(PG8_SB(0, 0), b2, voffB); PG8_STAGE(PG8_SB(0, 1), b2 + hstepB, voffB); PG8_STAGE(PG8_SA(0, 0), a2, voffA);
            PG8_WAIT_V(8); PG8_WAIT_L(0); PG8_BAR; PG8_MMA(1, 0, At, B0); PG8_MMA(1, 1, At, B1); PG8_BAR; PG8_SCHED;
            PG8_LDB(B0, 1, 0); PG8_LDB(B1, 1, 1); PG8_SCHED; PG8_LDA(At, 1, 0); PG8_STAGE(PG8_SA(0, 1), a2 + hstepA, voffA);
            PG8_WAIT_V(8); PG8_WAIT_L(0); PG8_BAR; PG8_MMA(0, 0, At, B0); PG8_MMA(0, 1, At, B1); PG8_BAR; PG8_SCHED;
            PG8_LDA(At, 1, 1); PG8_STAGE(PG8_SB(1, 0), b3, voffB); PG8_STAGE(PG8_SB(1, 1), b3 + hstepB, voffB); PG8_STAGE(PG8_SA(1, 0), a3, voffA);
            PG8_WAIT_V(8); PG8_WAIT_L(0); PG8_BAR; PG8_MMA(1, 0, At, B0); PG8_MMA(1, 1, At, B1); PG8_BAR; PG8_SCHED;
            } else {
            PG8_LDB(B0, 0, 0); PG8_SCHED; PG8_LDA(At, 0, 0); PG8_STAGE(PG8_SA(1, 1), a1 + hstepA, voffA);
            PG8_WAIT_L(8); PG8_BAR; PG8_WAIT_L(0); PG8_MMA(0, 0, At, B0); PG8_BAR; PG8_SCHED;
            PG8_LDB(B1, 0, 1); PG8_STAGE(PG8_SB(0, 0), b2, voffB);
            PG8_BAR; PG8_WAIT_L(0); PG8_MMA(0, 1, At, B1); PG8_BAR;
            PG8_LDA(At, 0, 1); PG8_STAGE(PG8_SA(0, 0), a2, voffA);
            PG8_BAR; PG8_WAIT_L(0); PG8_MMA(1, 0, At, B0); PG8_BAR; PG8_SCHED;
            PG8_STAGE(PG8_SB(0, 1), b2 + hstepB, voffB);
            PG8_WAIT_V(6); PG8_BAR; PG8_MMA(1, 1, At, B1); PG8_BAR;
            PG8_LDB(B0, 1, 0); PG8_SCHED; PG8_LDA(At, 1, 0); PG8_STAGE(PG8_SA(0, 1), a2 + hstepA, voffA);
            PG8_WAIT_L(8); PG8_BAR; PG8_WAIT_L(0); PG8_MMA(0, 0, At, B0); PG8_BAR; PG8_SCHED;
            PG8_LDB(B1, 1, 1); PG8_STAGE(PG8_SB(1, 0), b3, voffB);
            PG8_BAR; PG8_WAIT_L(0); PG8_MMA(0, 1, At, B1); PG8_BAR;
            PG8_LDA(At, 1, 1); PG8_STAGE(PG8_SA(1, 0), a3, voffA);
            PG8_BAR; PG8_WAIT_L(0); PG8_MMA(1, 0, At, B0); PG8_BAR; PG8_SCHED;
            PG8_STAGE(PG8_SB(1, 1), b3 + hstepB, voffB);
            PG8_WAIT_V(6); PG8_BAR; PG8_MMA(1, 1, At, B1); PG8_BAR;
            }
        }
        if constexpr (ALIGN_EPI) { if (wr == 0) PG8_BAR; }
        if constexpr (!Epi::AFTER_DRAIN) { E(acc, cur, wr, wc, fr, fq); S.done(cur); }
        if (!has_next) break;
#pragma unroll
        for (int a = 0; a < 2; ++a)
#pragma unroll
            for (int b = 0; b < 2; ++b)
#pragma unroll
                for (int m = 0; m < 4; ++m)
#pragma unroll
                    for (int n = 0; n < 2; ++n) acc[a][b][m][n] = (f32x4){0.f, 0.f, 0.f, 0.f};
        cur = nxt; cA = nA; cB = nB; ++ui;
        if constexpr (ALIGN_EPI) { if (wr == 1) PG8_BAR; }
    }
    PG8_WAIT_V(0);
    if constexpr (!ALIGN_EPI) { if (wr == 0) PG8_BAR; }
    PG8_BAR;
    if constexpr (Epi::AFTER_DRAIN) { E.fused(acc, cur, wr, wc, fr, fq, lds, wid, lane); S.done(cur); }
#undef PG8_SA
#undef PG8_SB
#undef PG8_STAGE
#undef PG8_LDA
#undef PG8_LDB
#undef PG8_MMA
#undef PG8_WAIT_V
#undef PG8_WAIT_L
#undef PG8_BAR
#undef PG8_SCHED
}
}

#define DI __device__ __forceinline__
#define LAS __attribute__((address_space(3)))
#define GAS __attribute__((address_space(1)))
typedef unsigned short bf16_t;
typedef float f32x4 __attribute__((ext_vector_type(4)));
typedef float f32x2 __attribute__((ext_vector_type(2)));
typedef unsigned u32x4 __attribute__((ext_vector_type(4)));
typedef unsigned u32x2 __attribute__((ext_vector_type(2)));
typedef short bf16x8 __attribute__((ext_vector_type(8)));
typedef short s16x4 __attribute__((ext_vector_type(4)));

constexpr int DM = 1024, SEQ = 4096, NLAYER = 4, MTOK = 32768, MH = 16384, INW = 7936, DFF = 4096, PLE = 256;
constexpr int UP = 4160;
constexpr int ZW = 4864;
constexpr int CQ = 0, CK = 768, CV = 1536, CX = 2304, CB = 2816, CC = 3328, CU = 3840, CVV = 4352, CG = 4864;
constexpr size_t MiB = 1u << 20;
constexpr size_t WS_ROPE = 0, WS_SSQA = 2 * MiB, WS_SSQB = 4 * MiB, WS_SSQC = 6 * MiB, WS_LSE = 8 * MiB, WS_DUMMY = 9 * MiB + 524288, WS_BAR = 9 * MiB + 655360, WS_SGW = 9 * MiB + 786432,
                 WS_WIN = 10 * MiB, WS_WBA = 26 * MiB, WS_WBB = 28 * MiB, WS_WBC = 29 * MiB, WS_WOUT3 = 30 * MiB, WS_WUP = 36 * MiB,
                 WS_WDOWN = 44 * MiB, WS_WPG = 53 * MiB, WS_WPE = 55 * MiB, WS_PBF = 56 * MiB, WS_HBA = 72 * MiB, WS_HBB = 136 * MiB,
                 WS_BIG = 200 * MiB, WS_PP = 460 * MiB, WS_G = 504 * MiB, WS_END = 568 * MiB;
constexpr int LDS_BYTES = 147456;
constexpr int NPHASE = 2 + NLAYER * 9;

struct Args { const void* in[21]; float* out; unsigned char* ws; float invf[8]; int ph_lo, ph_hi; };

using pg8::cvt_pk_bf16;
DI float bf_lo(unsigned w) { return __uint_as_float(w << 16); }
DI float bf_hi(unsigned w) { return __uint_as_float(w & 0xffff0000u); }
DI int lane_id_opaque() { int l; asm volatile("v_mbcnt_lo_u32_b32 %0, -1, 0\n\tv_mbcnt_hi_u32_b32 %0, -1, %0" : "=v"(l)); return l; }
template <int X> DI float lane_xor(float v) {
    return __int_as_float(__builtin_amdgcn_ds_swizzle(__float_as_int(v), (X << 10) | 0x1f));
}
DI float sum_xor32(float v) { auto rr = __builtin_amdgcn_permlane32_swap(__float_as_uint(v), __float_as_uint(v), false, false); return __uint_as_float(rr[0]) + __uint_as_float(rr[1]); }
DI float max_xor32(float v) { auto rr = __builtin_amdgcn_permlane32_swap(__float_as_uint(v), __float_as_uint(v), false, false); return fmaxf(__uint_as_float(rr[0]), __uint_as_float(rr[1])); }
DI float wave_sum(float v) {
    v += lane_xor<1>(v); v += lane_xor<2>(v); v += lane_xor<4>(v); v += lane_xor<8>(v); v += lane_xor<16>(v);
    return sum_xor32(v);
}
DI float sigmoidf_fast(float x) { return __builtin_amdgcn_rcpf(1.0f + __builtin_amdgcn_exp2f(-1.4426950408889634f * x)); }
DI float row_rstd(const float* ssq, int row, int fq) {
    const f32x4 v = *(const GAS f32x4*)(ssq + (size_t)row * 16 + 4 * fq);
    float s = (v.x + v.y) + (v.z + v.w);
    s += lane_xor<16>(s); s = sum_xor32(s);
    return 1.0f / sqrtf(s * (1.0f / 1024.0f) + 1e-6f);
}

typedef const f32x4 (&AccRef)[2][2][4][2];
#define EPI_ROWS_BEGIN _Pragma("unroll") for (int ai = 0; ai < 2; ++ai) _Pragma("unroll") for (int m = 0; m < 4; ++m) { const int lrow = u.pm * 256 + ai * 128 + wr * 64 + m * 16 + fr;
#define EPI_COLS_BEGIN _Pragma("unroll") for (int bj = 0; bj < 2; ++bj) { const int col = u.pn * 256 + bj * 128 + wc * 32 + 8 * fq; f32x4 v0 = acc[ai][bj][m][0], v1 = acc[ai][bj][m][1];
#define EPI_END }
#define EPI_ROW_END }
#define EPI_PRELOAD_RSTD(ssqptr) float rs8[8]; { f32x4 q8_[8]; \
    _Pragma("unroll") for (int ai = 0; ai < 2; ++ai) _Pragma("unroll") for (int m = 0; m < 4; ++m) q8_[ai * 4 + m] = *(const GAS f32x4*)((ssqptr) + (size_t)(u.pm * 256 + ai * 128 + wr * 64 + m * 16 + fr) * 16 + 4 * fq); \
    asm volatile("" ::: "memory");     \
    _Pragma("unroll") for (int i_ = 0; i_ < 8; ++i_) { float s_ = (q8_[i_].x + q8_[i_].y) + (q8_[i_].z + q8_[i_].w); s_ += lane_xor<16>(s_); s_ = sum_xor32(s_); rs8[i_] = 1.0f / sqrtf(s_ * (1.0f / 1024.0f) + 1e-6f); } } \
    asm volatile("" ::: "memory");

struct EpiIn {
    static constexpr bool PERM = true, AFTER_DRAIN = false;
    bf16_t* Z; const float* ssq; const float* rope; bf16_t* dummy; int ldz, kind_force;
    DI void operator()(AccRef acc, const pg8::Unit& u, int wr, int wc, int, int) const {
        const int lane_ = lane_id_opaque(), fr = lane_ & 15, fq = lane_ >> 4;
        const int pn = u.pn;
        const int kind = dummy ? 2 : (kind_force >= 0 ? kind_force : (pn < 6 ? (pn < 3 ? 0 : 1) : (pn < 15 ? 2 : (pn < 19 ? 3 : 4))));
        const bool rot = (kind < 2) && ((wc & 1) == 0);
        const float qs = (kind == 0) ? 0.125f : 1.0f;
        EPI_PRELOAD_RSTD(ssq)
#pragma unroll
        for (int ai = 0; ai < 2; ++ai) {
        f32x4 rc0[4], rc1[4], rs0[4], rs1[4];
#pragma unroll
        for (int m = 0; m < 4; ++m) { rc0[m] = (f32x4){1.f, 1.f, 1.f, 1.f}; rc1[m] = rc0[m]; rs0[m] = (f32x4){0.f, 0.f, 0.f, 0.f}; rs1[m] = rs0[m]; }
        if (rot) {
#pragma unroll
            for (int m = 0; m < 4; ++m) { const GAS f32x4* rp = (const GAS f32x4*)(rope + (size_t)(u.pm * 256 + ai * 128 + wr * 64 + m * 16 + fr) * 16); rc0[m] = rp[0]; rc1[m] = rp[1]; rs0[m] = rp[2]; rs1[m] = rp[3]; }
        }
        asm volatile("" ::: "memory");
#pragma unroll
        for (int m = 0; m < 4; ++m) { const int lrow = u.pm * 256 + ai * 128 + wr * 64 + m * 16 + fr;
            const float rs = rs8[ai * 4 + m];
            const f32x4 c0 = rc0[m], c1 = rc1[m], s0 = rs0[m], s1 = rs1[m];
            EPI_COLS_BEGIN
                v0 = v0 * rs; v1 = v1 * rs;
                if (kind < 2) {
                    if (rot) {
                        f32x4 p0, p1;
#pragma unroll
                        for (int e = 0; e < 4; ++e) { p0[e] = lane_xor<16>(v0[e]); p1[e] = lane_xor<16>(v1[e]); }
                        if (fq == 0) { v0 = v0 * c0 - p0 * s0; v1 = v1 * c1 - p1 * s1; }
                        else if (fq == 1) { v0 = v0 * c0 + p0 * s0; v1 = v1 * c1 + p1 * s1; }
                    }
                    v0 = v0 * qs; v1 = v1 * qs;
                } else if (kind == 3) {
                    f32x2 a = pg8::gelu_pk((f32x2){v0[0], v0[1]}), b = pg8::gelu_pk((f32x2){v0[2], v0[3]}), c = pg8::gelu_pk((f32x2){v1[0], v1[1]}), d = pg8::gelu_pk((f32x2){v1[2], v1[3]});
                    v0 = (f32x4){a.x, a.y, b.x, b.y}; v1 = (f32x4){c.x, c.y, d.x, d.y};
                } else if (kind == 4) {
#pragma unroll
                    for (int e = 0; e < 4; ++e) { v0[e] = sigmoidf_fast(v0[e]); v1[e] = sigmoidf_fast(v1[e]); }
                }
                u32x4 w; w.x = cvt_pk_bf16(v0[0], v0[1]); w.y = cvt_pk_bf16(v0[2], v0[3]); w.z = cvt_pk_bf16(v1[0], v1[1]); w.w = cvt_pk_bf16(v1[2], v1[3]);
                *(GAS u32x4*)(dummy ? dummy + lane_ * 8 : Z + (size_t)lrow * ldz + col) = w;
            EPI_END
        }
        }
    }
};
struct EpiGate {
    static constexpr bool PERM = true, AFTER_DRAIN = false, HAS_LOADS = true;
    const bf16_t* G; bf16_t* Mo; int has_prev; bf16_t* dummy;
    DI void operator()(AccRef acc, const pg8::Unit& u, int wr, int wc, int, int) const {
        const int lane_ = lane_id_opaque(), fr = lane_ & 15, fq = lane_ >> 4;
#pragma unroll
        for (int ai = 0; ai < 2; ++ai) {
            u32x4 gq[4][2], pq[4][2];
#pragma unroll
            for (int m = 0; m < 4; ++m)
#pragma unroll
                for (int bj = 0; bj < 2; ++bj) {
                    const int lrow = u.pm * 256 + ai * 128 + wr * 64 + m * 16 + fr, col = u.pn * 256 + bj * 128 + wc * 32 + 8 * fq;
                    gq[m][bj] = *(const GAS u32x4*)(G + (size_t)lrow * DM + col);
                    pq[m][bj] = (u32x4){0u, 0u, 0u, 0u};
                    if (has_prev) pq[m][bj] = *(const GAS u32x4*)(Mo + (size_t)lrow * ZW + col);
                }
            asm volatile("" ::: "memory");
#pragma unroll
            for (int m = 0; m < 4; ++m) {
                const int lrow = u.pm * 256 + ai * 128 + wr * 64 + m * 16 + fr;
                EPI_COLS_BEGIN
                    const size_t off = (size_t)lrow * ZW + col;
                    const u32x4 g = gq[m][bj], p = pq[m][bj];
                    v0[0] = v0[0] * bf_lo(g.x) + bf_lo(p.x); v0[1] = v0[1] * bf_hi(g.x) + bf_hi(p.x); v0[2] = v0[2] * bf_lo(g.y) + bf_lo(p.y); v0[3] = v0[3] * bf_hi(g.y) + bf_hi(p.y);
                    v1[0] = v1[0] * bf_lo(g.z) + bf_lo(p.z); v1[1] = v1[1] * bf_hi(g.z) + bf_hi(p.z); v1[2] = v1[2] * bf_lo(g.w) + bf_lo(p.w); v1[3] = v1[3] * bf_hi(g.w) + bf_hi(p.w);
                    u32x4 w; w.x = cvt_pk_bf16(v0[0], v0[1]); w.y = cvt_pk_bf16(v0[2], v0[3]); w.z = cvt_pk_bf16(v1[0], v1[1]); w.w = cvt_pk_bf16(v1[2], v1[3]);
                    *(GAS u32x4*)(dummy ? dummy + lane_ * 8 : Mo + off) = w;
                EPI_END
            }
        }
    }
};
struct EpiRes {
    static constexpr bool PERM = true, AFTER_DRAIN = false, HAS_LOADS = true;
    const bf16_t* Hin; bf16_t* Hout; float* ssq_out; float* dummy;
    DI void operator()(AccRef acc, const pg8::Unit& u, int wr, int wc, int, int) const {
        const int lane_ = lane_id_opaque(), fr = lane_ & 15, fq = lane_ >> 4;
        u32x4 hv[2][4][2];
#pragma unroll
        for (int ai = 0; ai < 2; ++ai)
#pragma unroll
            for (int m = 0; m < 4; ++m)
#pragma unroll
                for (int bj = 0; bj < 2; ++bj)
                    hv[ai][m][bj] = *(const GAS u32x4*)(Hin + (size_t)(u.pm * 256 + ai * 128 + wr * 64 + m * 16 + fr) * DM + u.pn * 256 + bj * 128 + wc * 32 + 8 * fq);
        asm volatile("" ::: "memory");
        EPI_ROWS_BEGIN
            float ss = 0.f;
            EPI_COLS_BEGIN
                const size_t off = (size_t)lrow * DM + col;
                const u32x4 h4 = hv[ai][m][bj];
                v0[0] += bf_lo(h4.x); v0[1] += bf_hi(h4.x); v0[2] += bf_lo(h4.y); v0[3] += bf_hi(h4.y);
                v1[0] += bf_lo(h4.z); v1[1] += bf_hi(h4.z); v1[2] += bf_lo(h4.w); v1[3] += bf_hi(h4.w);
                ss += (v0[0] * v0[0] + v0[1] * v0[1]) + (v0[2] * v0[2] + v0[3] * v0[3]) + (v1[0] * v1[0] + v1[1] * v1[1]) + (v1[2] * v1[2] + v1[3] * v1[3]);
                u32x4 w; w.x = cvt_pk_bf16(v0[0], v0[1]); w.y = cvt_pk_bf16(v0[2], v0[3]); w.z = cvt_pk_bf16(v1[0], v1[1]); w.w = cvt_pk_bf16(v1[2], v1[3]);
                *(GAS u32x4*)(dummy ? (bf16_t*)(dummy + 2048) + lane_ * 8 : Hout + off) = w;
            EPI_END
            ss += lane_xor<16>(ss); ss = sum_xor32(ss);
            if (fq == 0) *(GAS float*)(dummy ? dummy + 4096 + lane_ : ssq_out + (size_t)lrow * 16 + u.pn * 4 + wc) = ss;
        EPI_ROW_END
    }
};
struct EpiUp {
    static constexpr bool PERM = true, AFTER_DRAIN = false;
    bf16_t* U; const float* ssq;
    DI void operator()(AccRef acc, const pg8::Unit& u, int wr, int wc, int, int) const {
        const int lane_ = lane_id_opaque(), fr = lane_ & 15, fq = lane_ >> 4;
        EPI_PRELOAD_RSTD(ssq)
        EPI_ROWS_BEGIN
            const float rs = rs8[ai * 4 + m];
            EPI_COLS_BEGIN
#pragma unroll
                for (int e = 0; e < 4; ++e) { float a = fmaxf(v0[e] * rs, 0.f), b = fmaxf(v1[e] * rs, 0.f); v0[e] = a * a; v1[e] = b * b; }
                u32x4 w; w.x = cvt_pk_bf16(v0[0], v0[1]); w.y = cvt_pk_bf16(v0[2], v0[3]); w.z = cvt_pk_bf16(v1[0], v1[1]); w.w = cvt_pk_bf16(v1[2], v1[3]);
                *(GAS u32x4*)(U + (size_t)lrow * UP + col) = w;
            EPI_END
        EPI_ROW_END
    }
};
struct EpiPlain {
    static constexpr bool PERM = true, AFTER_DRAIN = false;
    bf16_t* O; int ldc;
    DI void operator()(AccRef acc, const pg8::Unit& u, int wr, int wc, int, int) const {
        const int lane_ = lane_id_opaque(), fr = lane_ & 15, fq = lane_ >> 4;
        EPI_ROWS_BEGIN
            EPI_COLS_BEGIN
                u32x4 w; w.x = cvt_pk_bf16(v0[0], v0[1]); w.y = cvt_pk_bf16(v0[2], v0[3]); w.z = cvt_pk_bf16(v1[0], v1[1]); w.w = cvt_pk_bf16(v1[2], v1[3]);
                *(GAS u32x4*)(O + (size_t)lrow * ldc + col) = w;
            EPI_END
        EPI_ROW_END
    }
};
struct EpiPle {
    static constexpr bool PERM = true, AFTER_DRAIN = false, HAS_LOADS = true;
    const bf16_t* Hin; const bf16_t* PP; const float* ssq; bf16_t* Hout; float* ssq_out; float* dummy;
    DI void operator()(AccRef acc, const pg8::Unit& u, int wr, int wc, int, int) const {
        const int lane_ = lane_id_opaque(), fr = lane_ & 15, fq = lane_ >> 4;
        EPI_PRELOAD_RSTD(ssq)
#pragma unroll
        for (int ai = 0; ai < 2; ++ai) {
            u32x4 hq[4][2];
#pragma unroll
            for (int m = 0; m < 4; ++m)
#pragma unroll
                for (int bj = 0; bj < 2; ++bj)
                    hq[m][bj] = *(const GAS u32x4*)(Hin + (size_t)(u.pm * 256 + ai * 128 + wr * 64 + m * 16 + fr) * DM + u.pn * 256 + bj * 128 + wc * 32 + 8 * fq);
            asm volatile("" ::: "memory");
#pragma unroll
            for (int mp = 0; mp < 2; ++mp) {
                u32x4 gq[2][2];
#pragma unroll
                for (int mm = 0; mm < 2; ++mm)
#pragma unroll
                    for (int bj = 0; bj < 2; ++bj)
                        gq[mm][bj] = *(const GAS u32x4*)(PP + (size_t)(u.pm * 256 + ai * 128 + wr * 64 + (2 * mp + mm) * 16 + fr) * DM + u.pn * 256 + bj * 128 + wc * 32 + 8 * fq);
                asm volatile("" ::: "memory");
#pragma unroll
                for (int mm = 0; mm < 2; ++mm) {
                    const int m = 2 * mp + mm;
                    const int lrow = u.pm * 256 + ai * 128 + wr * 64 + m * 16 + fr;
                    const float rs = rs8[ai * 4 + m];
                    float ss = 0.f;
                    EPI_COLS_BEGIN
                        const size_t off = (size_t)lrow * DM + col;
                        const u32x4 g = gq[mm][bj], hv = hq[m][bj];
                        v0[0] = bf_lo(hv.x) + sigmoidf_fast(v0[0] * rs) * bf_lo(g.x); v0[1] = bf_hi(hv.x) + sigmoidf_fast(v0[1] * rs) * bf_hi(g.x);
                        v0[2] = bf_lo(hv.y) + sigmoidf_fast(v0[2] * rs) * bf_lo(g.y); v0[3] = bf_hi(hv.y) + sigmoidf_fast(v0[3] * rs) * bf_hi(g.y);
                        v1[0] = bf_lo(hv.z) + sigmoidf_fast(v1[0] * rs) * bf_lo(g.z); v1[1] = bf_hi(hv.z) + sigmoidf_fast(v1[1] * rs) * bf_hi(g.z);
                        v1[2] = bf_lo(hv.w) + sigmoidf_fast(v1[2] * rs) * bf_lo(g.w); v1[3] = bf_hi(hv.w) + sigmoidf_fast(v1[3] * rs) * bf_hi(g.w);
                        ss += (v0[0] * v0[0] + v0[1] * v0[1]) + (v0[2] * v0[2] + v0[3] * v0[3]) + (v1[0] * v1[0] + v1[1] * v1[1]) + (v1[2] * v1[2] + v1[3] * v1[3]);
                        u32x4 w; w.x = cvt_pk_bf16(v0[0], v0[1]); w.y = cvt_pk_bf16(v0[2], v0[3]); w.z = cvt_pk_bf16(v1[0], v1[1]); w.w = cvt_pk_bf16(v1[2], v1[3]);
                        *(GAS u32x4*)(dummy ? (bf16_t*)(dummy + 2048) + lane_ * 8 : Hout + off) = w;
                    EPI_END
                    ss += lane_xor<16>(ss); ss = sum_xor32(ss);
                    if (fq == 0) *(GAS float*)(dummy ? dummy + 4096 + lane_ : ssq_out + (size_t)lrow * 16 + u.pn * 4 + wc) = ss;
                }
            }
        }
    }
};

template <class Epi>
DI void run_gemm(LAS unsigned char* lds, int bid, int gsz, int wave, const bf16_t* A, int lda, const bf16_t* Bt, int M, int N, int K, const Epi& E, int ldb = 0) {
    if (ldb == 0) ldb = K;
    pg8::Gemm g{A, lda, Bt, ldb, M, N, K, wave};
    pg8::StaticOrder S; S.init(M, N, gsz, bid);
    pg8::gemm_phase<Epi, pg8::StaticOrder, true, true>(lds, g, S, E);
}

DI void transpose_item(const float* W_, int K, int N, bf16_t* WT, int ldk, int koff, const float* gk_, LAS float* scr, int item, int lane) {
    const GAS float* W = (const GAS float*)W_; const GAS float* gk = (const GAS float*)gk_;
    const int nblk = N / 32, kb = item / nblk, nb = item % nblk, k0 = 64 * kb, n0 = 32 * nb;
    float wv_[32];
#pragma unroll
    for (int i = 0; i < 32; ++i) wv_[i] = W[(size_t)(k0 + 2 * i + (lane >> 5)) * N + n0 + (lane & 31)];
#pragma unroll
    for (int i = 0; i < 32; ++i) { const int kk = 2 * i + (lane >> 5); float v = wv_[i]; if (gk) v *= gk[k0 + kk]; scr[kk * 33 + (lane & 31)] = v; }
    asm volatile("s_waitcnt lgkmcnt(0)" ::: "memory");
    const int c = lane & 7;
#pragma unroll
    for (int j = 0; j < 4; ++j) { const int n = (lane >> 3) + 8 * j; const LAS float* s = scr + (8 * c) * 33 + n;
        u32x4 o; o.x = cvt_pk_bf16(s[0 * 33], s[1 * 33]); o.y = cvt_pk_bf16(s[2 * 33], s[3 * 33]); o.z = cvt_pk_bf16(s[4 * 33], s[5 * 33]); o.w = cvt_pk_bf16(s[6 * 33], s[7 * 33]);
        *(GAS u32x4*)(WT + (size_t)(n0 + n) * ldk + koff + k0 + 8 * c) = o; }
    asm volatile("s_waitcnt lgkmcnt(0)" ::: "memory");
}

constexpr int ARG_OFF = 131072;
DI const void* argp(LAS unsigned char* lds, int k) {
    unsigned a_ = ARG_OFF; asm volatile("" : "+s"(a_));
    const unsigned long long v = ((const LAS unsigned long long*)(lds + a_))[k];
    const unsigned lo = __builtin_amdgcn_readfirstlane((unsigned)v), hi = __builtin_amdgcn_readfirstlane((unsigned)(v >> 32));
    return (const void*)(((unsigned long long)hi << 32) | lo);
}
struct Ctx {
    LAS unsigned char* lds; unsigned char* ws; int tid, lane, wave, gw, ngw, bid, gsz;
};

DI void phase_prologue(const Ctx& C) {
    const GAS float* x = (const GAS float*)argp(C.lds, 0); const GAS int* pos = (const GAS int*)argp(C.lds, 2);
    GAS bf16_t* hbB = (GAS bf16_t*)(C.ws + WS_HBB); GAS float* ssqC = (GAS float*)(C.ws + WS_SSQC); GAS float* rope = (GAS float*)(C.ws + WS_ROPE);
    for (int m0 = C.gw; m0 < MTOK; m0 += 4 * C.ngw) {
        f32x4 v[4][4];
#pragma unroll
        for (int k = 0; k < 4; ++k) { const int m = m0 + k * C.ngw; if (m < MTOK) { const GAS f32x4* xr = (const GAS f32x4*)(x + (size_t)m * DM) + C.lane;
#pragma unroll
            for (int j = 0; j < 4; ++j) v[k][j] = xr[64 * j]; } }
#pragma unroll
        for (int k = 0; k < 4; ++k) { const int m = m0 + k * C.ngw; if (m < MTOK) {
            GAS u32x2* br = (GAS u32x2*)(hbB + (size_t)m * DM) + C.lane; float s = 0.f;
#pragma unroll
            for (int j = 0; j < 4; ++j) { const f32x4 t = v[k][j]; s += (t.x * t.x + t.y * t.y) + (t.z * t.z + t.w * t.w);
                u32x2 w; w.x = cvt_pk_bf16(t.x, t.y); w.y = cvt_pk_bf16(t.z, t.w); br[64 * j] = w; }
            s = wave_sum(s);
            if (C.lane < 16) ssqC[(size_t)m * 16 + C.lane] = (C.lane == 0) ? s : 0.f; } }
    }
    const int gt = C.gw * 64 + C.lane, ngt = C.ngw * 64;
    for (int tok = gt; tok < MTOK; tok += ngt) {
        const float pf = (float)pos[tok];
#pragma unroll
        for (int j = 0; j < 8; ++j) {
            const float ang = __fmul_rn(pf, ((const LAS float*)(C.lds + ARG_OFF + 23 * 8))[j]);
            const double rev = (double)ang * 0.15915494309189535; const float frc = (float)(rev - __builtin_rint(rev));
            rope[(size_t)tok * 16 + j] = __builtin_amdgcn_cosf(frc); rope[(size_t)tok * 16 + 8 + j] = __builtin_amdgcn_sinf(frc);
        }
    }
}

DI void phase_convert(const Ctx& C, int L) {
    LAS float* scr = (LAS float*)(C.lds + C.wave * 16384);
    const float* w_in = (const float*)argp(C.lds, 4) + (size_t)L * DM * INW; const float* g_mix = (const float*)argp(C.lds, 3) + L * DM;
    const float* w_ba = (const float*)argp(C.lds, 10) + (size_t)L * 768 * DM; const float* w_bb = (const float*)argp(C.lds, 11) + (size_t)L * 512 * DM; const float* w_bc = (const float*)argp(C.lds, 12) + (size_t)L * 512 * DM;
    const float* w_out = (const float*)argp(C.lds, 13) + (size_t)L * DM * DM;
    const float* w_up = (const float*)argp(C.lds, 15) + (size_t)L * DM * DFF; const float* g_mlp = (const float*)argp(C.lds, 14) + L * DM;
    const float* w_down = (const float*)argp(C.lds, 16) + (size_t)L * DFF * DM;
    const float* w_pg = (const float*)argp(C.lds, 18) + (size_t)L * DM * DM; const float* g_ple = (const float*)argp(C.lds, 17) + L * DM;
    const float* w_pe = (const float*)argp(C.lds, 19) + (size_t)L * PLE * DM;
    constexpr int I_IN = 16 * (INW / 32), I_BA = 12 * 32, I_BB = 8 * 32, I_OUT = 16 * 32, I_UP = 16 * (DFF / 32), I_DOWN = 64 * 32, I_PG = 16 * 32, I_PE = 4 * 32;
    constexpr int NITEMS = I_IN + I_BA + 2 * I_BB + I_OUT + I_UP + I_DOWN + I_PG + I_PE;
    for (int it = C.gw; it < NITEMS; it += C.ngw) {
        int r = it;
        if (r < I_IN) { transpose_item(w_in, DM, INW, (bf16_t*)(C.ws + WS_WIN), DM, 0, g_mix, scr, r, C.lane); continue; } r -= I_IN;
        if (r < I_BA) { transpose_item(w_ba, 768, DM, (bf16_t*)(C.ws + WS_WBA), 768, 0, nullptr, scr, r, C.lane); continue; } r -= I_BA;
        if (r < I_BB) { transpose_item(w_bb, 512, DM, (bf16_t*)(C.ws + WS_WBB), 512, 0, nullptr, scr, r, C.lane); continue; } r -= I_BB;
        if (r < I_BB) { transpose_item(w_bc, 512, DM, (bf16_t*)(C.ws + WS_WBC), 512, 0, nullptr, scr, r, C.lane); continue; } r -= I_BB;
        if (r < I_OUT) { transpose_item(w_out, DM, DM, (bf16_t*)(C.ws + WS_WOUT3), DM, 0, nullptr, scr, r, C.lane); continue; } r -= I_OUT;
        if (r < I_UP) { transpose_item(w_up, DM, DFF, (bf16_t*)(C.ws + WS_WUP), DM, 0, g_mlp, scr, r, C.lane); continue; } r -= I_UP;
        if (r < I_DOWN) { transpose_item(w_down, DFF, DM, (bf16_t*)(C.ws + WS_WDOWN), UP, 0, nullptr, scr, r, C.lane); continue; } r -= I_DOWN;
        if (r < I_PG) { transpose_item(w_pg, DM, DM, (bf16_t*)(C.ws + WS_WPG), DM, 0, g_ple, scr, r, C.lane); continue; } r -= I_PG;
        transpose_item(w_pe, PLE, DM, (bf16_t*)(C.ws + WS_WPE), PLE, 0, nullptr, scr, r, C.lane);
    }
    const int gt = C.gw * 64 + C.lane, ngt = C.ngw * 64;
    const float* p = (const float*)argp(C.lds, 1) + (size_t)L * MTOK * PLE; bf16_t* pbf = (bf16_t*)(C.ws + WS_PBF);
    for (int i = gt; i < MTOK * PLE / 8; i += ngt) {
        const f32x4 a = *(const GAS f32x4*)(p + (size_t)i * 8), b = *(const GAS f32x4*)(p + (size_t)i * 8 + 4);
        u32x4 w; w.x = cvt_pk_bf16(a.x, a.y); w.y = cvt_pk_bf16(a.z, a.w); w.z = cvt_pk_bf16(b.x, b.y); w.w = cvt_pk_bf16(b.z, b.w);
        *(GAS u32x4*)(pbf + (size_t)i * 8) = w;
    }
    const GAS float* sgw = (const GAS float*)argp(C.lds, 8) + (size_t)L * 4 * 128 * 128; bf16_t* sgb = (bf16_t*)(C.ws + WS_SGW);
    for (int i = gt; i < 4 * 128 * 128 / 2; i += ngt) {
        const int e = i * 2, s = e & 127, t = (e >> 7) & 127;
        const float a = (s <= t) ? sgw[e] : 0.f, b = (s + 1 <= t) ? sgw[e + 1] : 0.f;
        *(GAS unsigned*)(sgb + e) = cvt_pk_bf16(a, b);
    }
}

DI void phase_attn(const Ctx& C, bf16_t* Z, float* lse, bool dry) {
    const int tid = C.tid, lane = C.lane, w = C.wave, fr = lane & 15, fq = lane >> 4;
    LAS bf16_t* Ks = (LAS bf16_t*)C.lds;
    LAS bf16_t* Vt = (LAS bf16_t*)(C.lds + 36864);
    const int upc = 3072 / C.gsz, urem = 3072 - upc * C.gsz, nmine = upc + (C.bid < urem ? 1 : 0);
    int cslot = 1;
    for (int ui = 0; ui < nmine; ++ui) {
        const int uid = ui < upc ? C.bid * upc + ui : C.gsz * upc + C.bid;
        const int j = uid & 31, head = (uid >> 5) % 12, bl = uid / 384;
        const int g = head >> 2, dsh = 2 * g, nsh = 5 - dsh;
        const int r = j >> nsh, n = j & ((1 << nsh) - 1);
        const size_t rowb = (size_t)bl * SEQ + r;
        const bool reuse = (ui > 0) && (ui < upc) && (n > 0);
        cslot = reuse ? (cslot ^ 1) : 1;
        const int rot = 128 * (1 - cslot), rot16 = rot >> 4;
#pragma unroll
        for (int cc = 0; cc < 4; ++cc) {
            if (cc < 2 && reuse) continue;
            const int c = tid + cc * 512, kj = c >> 3, ch = c & 7, mm = (n - 1) * 128 + kj, pk = (kj + rot) & 255;
            u32x4 kv = {0u, 0u, 0u, 0u}, vv = {0u, 0u, 0u, 0u};
            if (mm >= 0) { const bf16_t* p = Z + (rowb + ((size_t)mm << dsh)) * ZW + head * 64 + ch * 8; kv = *(const GAS u32x4*)(p + CK); vv = *(const GAS u32x4*)(p + CV); }
            *(LAS u32x4*)(Ks + pk * 72 + ch * 8) = kv;
            LAS bf16_t* vp = Vt + (ch * 8) * 264 + (pk ^ (ch << 3));
            vp[0 * 264] = (bf16_t)(vv.x & 0xffffu); vp[1 * 264] = (bf16_t)(vv.x >> 16);
            vp[2 * 264] = (bf16_t)(vv.y & 0xffffu); vp[3 * 264] = (bf16_t)(vv.y >> 16);
            vp[4 * 264] = (bf16_t)(vv.z & 0xffffu); vp[5 * 264] = (bf16_t)(vv.z >> 16);
            vp[6 * 264] = (bf16_t)(vv.w & 0xffffu); vp[7 * 264] = (bf16_t)(vv.w >> 16);
        }
        const int qi = 16 * w + fr; const size_t qrow = rowb + ((size_t)(n * 128 + qi) << dsh);
        bf16_t* qp = Z + qrow * ZW + head * 64;
        const bf16x8 qf0 = *(const GAS bf16x8*)(qp + 8 * fq), qf1 = *(const GAS bf16x8*)(qp + 32 + 8 * fq);
        __syncthreads();
        const int t0 = w < 6 ? w : 6;
        f32x4 st[10];
#pragma unroll
        for (int x = 0; x < 10; ++x) {
            const LAS bf16_t* kp = Ks + (16 * ((t0 + x + rot16) & 15) + fr) * 72 + 8 * fq;
            const bf16x8 a0 = *(const LAS bf16x8*)kp, a1 = *(const LAS bf16x8*)(kp + 32);
            f32x4 acc = {0.f, 0.f, 0.f, 0.f};
            acc = __builtin_amdgcn_mfma_f32_16x16x32_bf16(a0, qf0, acc, 0, 0, 0);
            acc = __builtin_amdgcn_mfma_f32_16x16x32_bf16(a1, qf1, acc, 0, 0, 0);
            st[x] = acc;
        }
        float mx = -INFINITY;
#pragma unroll
        for (int x = 0; x < 10; ++x)
#pragma unroll
            for (int i = 0; i < 4; ++i) {
                const int kj = 16 * (t0 + x) + 4 * fq + i, dist = qi + 128 - kj;
                const bool valid = (dist >= 0) && (dist <= 128) && (n > 0 || kj >= 128);
                const float s = valid ? st[x][i] : -INFINITY; st[x][i] = s; mx = fmaxf(mx, s);
            }
        mx = fmaxf(mx, lane_xor<16>(mx)); mx = max_xor32(mx);
        float sum = 0.f;
#pragma unroll
        for (int x = 0; x < 10; ++x)
#pragma unroll
            for (int i = 0; i < 4; ++i) { const float p = __builtin_amdgcn_exp2f((st[x][i] - mx) * 1.4426950408889634f); st[x][i] = p; sum += p; }
        sum += lane_xor<16>(sum); sum = sum_xor32(sum);
        f32x4 o[4];
#pragma unroll
        for (int dt = 0; dt < 4; ++dt) o[dt] = (f32x4){0.f, 0.f, 0.f, 0.f};
#pragma unroll
        for (int y = 0; y < 5; ++y) {
            u32x4 pw; pw.x = cvt_pk_bf16(st[2 * y][0], st[2 * y][1]); pw.y = cvt_pk_bf16(st[2 * y][2], st[2 * y][3]);
            pw.z = cvt_pk_bf16(st[2 * y + 1][0], st[2 * y + 1][1]); pw.w = cvt_pk_bf16(st[2 * y + 1][2], st[2 * y + 1][3]);
            const bf16x8 pb = __builtin_bit_cast(bf16x8, pw);
            const int ka = 16 * ((t0 + 2 * y + rot16) & 15) + 4 * fq, kb = 16 * ((t0 + 2 * y + 1 + rot16) & 15) + 4 * fq;
#pragma unroll
            for (int dt = 0; dt < 4; ++dt) {
                const LAS bf16_t* vr = Vt + (16 * dt + fr) * 264; const int sw = ((2 * dt + (fr >> 3)) & 7) << 3;
                const s16x4 va = *(const LAS s16x4*)(vr + (ka ^ sw)), vb = *(const LAS s16x4*)(vr + (kb ^ sw));
                const bf16x8 a = {va[0], va[1], va[2], va[3], vb[0], vb[1], vb[2], vb[3]};
                o[dt] = __builtin_amdgcn_mfma_f32_16x16x32_bf16(a, pb, o[dt], 0, 0, 0);
            }
        }
        const float inv = 1.0f / sum;
        bf16_t* qst = dry ? (bf16_t*)(C.ws + WS_PP) + tid * 64 : qp;
#pragma unroll
        for (int dt = 0; dt < 4; ++dt) {
            u32x2 wv; wv.x = cvt_pk_bf16(o[dt][0] * inv, o[dt][1] * inv); wv.y = cvt_pk_bf16(o[dt][2] * inv, o[dt][3] * inv);
            *(GAS u32x2*)(qst + 16 * dt + 4 * fq) = wv;
        }
        if (fq == 0) *(GAS float*)(dry ? (float*)(C.ws + WS_PP) + 1048576 + tid : lse + qrow * 12 + head) = mx + __builtin_amdgcn_logf(sum) * 0.6931471805599453f;
        __syncthreads();
    }
}

DI void phase_mix(const Ctx& C, bf16_t* Z, const float* lse_, int L, bool dry) {
    const GAS float* lse = (const GAS float*)lse_;
    bf16_t* dummy = (bf16_t*)(C.ws + WS_PP) + C.tid * 64;
    const int gt = C.bid * 512 + C.tid, ngt = C.gsz * 512;
    for (int base = gt; base < MTOK * 96; base += 8 * ngt) {
        u32x4 v[8]; float l0[8], l1[8], l2[8];
#pragma unroll
        for (int k = 0; k < 8; ++k) {
            const int idx = base + k * ngt;
            if (idx < MTOK * 96) {
                const int lrow = idx / 96, rem = idx - lrow * 96, head = rem >> 3, ch = rem & 7, slot = head & 3;
                l0[k] = lse[(size_t)lrow * 12 + slot]; l1[k] = lse[(size_t)lrow * 12 + 4 + slot]; l2[k] = lse[(size_t)lrow * 12 + 8 + slot];
                v[k] = *(const GAS u32x4*)(Z + (size_t)lrow * ZW + head * 64 + ch * 8);
            }
        }
#pragma unroll
        for (int k = 0; k < 8; ++k) {
            const int idx = base + k * ngt;
            if (idx < MTOK * 96) {
                const int lrow = idx / 96, rem = idx - lrow * 96, head = rem >> 3, ch = rem & 7, g = head >> 2;
                const float mx = fmaxf(l0[k], fmaxf(l1[k], l2[k]));
                const float e0 = __builtin_amdgcn_exp2f((l0[k] - mx) * 1.4426950408889634f), e1 = __builtin_amdgcn_exp2f((l1[k] - mx) * 1.4426950408889634f), e2 = __builtin_amdgcn_exp2f((l2[k] - mx) * 1.4426950408889634f);
                const float al = (g == 0 ? e0 : (g == 1 ? e1 : e2)) / (e0 + e1 + e2);
                bf16_t* p = Z + (size_t)lrow * ZW + head * 64 + ch * 8;
                u32x4 w;
                w.x = cvt_pk_bf16(bf_lo(v[k].x) * al, bf_hi(v[k].x) * al); w.y = cvt_pk_bf16(bf_lo(v[k].y) * al, bf_hi(v[k].y) * al);
                w.z = cvt_pk_bf16(bf_lo(v[k].z) * al, bf_hi(v[k].z) * al); w.w = cvt_pk_bf16(bf_lo(v[k].w) * al, bf_hi(v[k].w) * al);
                *(GAS u32x4*)(dry ? dummy : p) = w;
            }
        }
    }
    const float* cw = (const float*)argp(C.lds, 5) + (size_t)L * 3 * 512;
    for (int base = gt; base < MTOK * 64; base += 4 * ngt) {
        u32x4 xv[4][3], cv[4][3], bv[4];
#pragma unroll
        for (int k = 0; k < 4; ++k) {
            const int idx = base + k * ngt; const int lrow = idx >> 6, c0 = (idx & 63) * 8, t = lrow & (SEQ - 1);
#pragma unroll
            for (int jj = 0; jj < 3; ++jj) {
                const int back = 2 - jj; xv[k][jj] = (u32x4){0u, 0u, 0u, 0u}; cv[k][jj] = (u32x4){0u, 0u, 0u, 0u};
                if (idx < MTOK * 64 && t >= back) { const bf16_t* zr = Z + (size_t)(lrow - back) * ZW + c0; xv[k][jj] = *(const GAS u32x4*)(zr + CX); cv[k][jj] = *(const GAS u32x4*)(zr + CC); }
            }
            bv[k] = (u32x4){0u, 0u, 0u, 0u};
            if (idx < MTOK * 64) bv[k] = *(const GAS u32x4*)(Z + (size_t)lrow * ZW + CB + c0);
        }
#pragma unroll
        for (int k = 0; k < 4; ++k) {
            const int idx = base + k * ngt; const int lrow = idx >> 6, c0 = (idx & 63) * 8;
            if (idx < MTOK * 64) {
                float accv[8];
#pragma unroll
                for (int e = 0; e < 8; ++e) accv[e] = 0.f;
#pragma unroll
                for (int jj = 0; jj < 3; ++jj) {
                    const f32x4 w0 = *(const GAS f32x4*)(cw + jj * 512 + c0), w1 = *(const GAS f32x4*)(cw + jj * 512 + c0 + 4);
                    const u32x4 x_ = xv[k][jj], c_ = cv[k][jj];
                    accv[0] += w0.x * bf_lo(x_.x) * bf_lo(c_.x); accv[1] += w0.y * bf_hi(x_.x) * bf_hi(c_.x);
                    accv[2] += w0.z * bf_lo(x_.y) * bf_lo(c_.y); accv[3] += w0.w * bf_hi(x_.y) * bf_hi(c_.y);
                    accv[4] += w1.x * bf_lo(x_.z) * bf_lo(c_.z); accv[5] += w1.y * bf_hi(x_.z) * bf_hi(c_.z);
                    accv[6] += w1.z * bf_lo(x_.w) * bf_lo(c_.w); accv[7] += w1.w * bf_hi(x_.w) * bf_hi(c_.w);
                }
                bf16_t* bp = Z + (size_t)lrow * ZW + CB + c0;
                u32x4 w;
                w.x = cvt_pk_bf16(bf_lo(bv[k].x) * accv[0], bf_hi(bv[k].x) * accv[1]); w.y = cvt_pk_bf16(bf_lo(bv[k].y) * accv[2], bf_hi(bv[k].y) * accv[3]);
                w.z = cvt_pk_bf16(bf_lo(bv[k].z) * accv[4], bf_hi(bv[k].z) * accv[5]); w.w = cvt_pk_bf16(bf_lo(bv[k].w) * accv[6], bf_hi(bv[k].w) * accv[7]);
                *(GAS u32x4*)(dry ? dummy : bp) = w;
            }
        }
    }
    const int lane = C.lane, w = C.wave, fr = lane & 15, fq = lane >> 4, tid = C.tid;
    LAS bf16_t* Vt2 = (LAS bf16_t*)C.lds;
    LAS float* stat = (LAS float*)(C.lds + 34816);
    const bf16_t* sgw = (const bf16_t*)(C.ws + WS_SGW);
    const float* ln_g = (const float*)argp(C.lds, 6) + L * 512; const float* ln_b = (const float*)argp(C.lds, 7) + L * 512; const GAS float* sg_b = (const GAS float*)argp(C.lds, 9) + L * 512;
    for (int ck = C.bid; ck < MTOK / 128; ck += C.gsz) {
        const int row0 = ck * 128;
        {
            const int tk = tid >> 2, q4 = tid & 3;
            const bf16_t* vr = Z + (size_t)(row0 + tk) * ZW + CVV + q4 * 128;
            float s1 = 0.f, s2 = 0.f;
#pragma unroll
            for (int i = 0; i < 16; ++i) {
                const u32x4 raw = *(const GAS u32x4*)(vr + i * 8);
                const float x0 = bf_lo(raw.x), x1 = bf_hi(raw.x), x2 = bf_lo(raw.y), x3 = bf_hi(raw.y), x4 = bf_lo(raw.z), x5 = bf_hi(raw.z), x6 = bf_lo(raw.w), x7 = bf_hi(raw.w);
                s1 += ((x0 + x1) + (x2 + x3)) + ((x4 + x5) + (x6 + x7));
                s2 += ((x0 * x0 + x1 * x1) + (x2 * x2 + x3 * x3)) + ((x4 * x4 + x5 * x5) + (x6 * x6 + x7 * x7));
            }
            s1 += lane_xor<1>(s1); s1 += lane_xor<2>(s1); s2 += lane_xor<1>(s2); s2 += lane_xor<2>(s2);
            const float mean = s1 * (1.0f / 512.0f), var = fmaxf(s2 * (1.0f / 512.0f) - mean * mean, 0.f);
            if (q4 == 0) { stat[tk * 2] = mean; stat[tk * 2 + 1] = 1.0f / sqrtf(var + 1e-5f); }
        }
        __syncthreads();
        u32x4 raw[4];
#pragma unroll
        for (int cc = 0; cc < 4; ++cc) { const int c = tid + cc * 512, tk = c >> 4, ch = c & 15; raw[cc] = *(const GAS u32x4*)(Z + (size_t)(row0 + tk) * ZW + CVV + ch * 8); }
        for (int g = 0; g < 4; ++g) {
        const int tkE = 16 * w + fr;
        bf16_t* up = Z + (size_t)(row0 + tkE) * ZW + CU + g * 128 + 4 * fq;
        u32x2 uq[8];
#pragma unroll
        for (int ct = 0; ct < 8; ++ct) uq[ct] = *(const GAS u32x2*)(up + 16 * ct);
        const float bias = sg_b[g * 128 + tkE];
#pragma unroll
        for (int cc = 0; cc < 4; ++cc) {
            const int c = tid + cc * 512, tk = c >> 4, ch = c & 15, c0 = g * 128 + ch * 8;
            const u32x4 rw = raw[cc];
            const float mean = stat[tk * 2], rstd = stat[tk * 2 + 1];
            const f32x4 g0 = *(const GAS f32x4*)(ln_g + c0), g1 = *(const GAS f32x4*)(ln_g + c0 + 4), b0 = *(const GAS f32x4*)(ln_b + c0), b1 = *(const GAS f32x4*)(ln_b + c0 + 4);
            LAS bf16_t* vp = Vt2 + (ch * 8) * 136 + (tk ^ (ch << 3));
            const unsigned p0 = cvt_pk_bf16((bf_lo(rw.x) - mean) * rstd * g0.x + b0.x, (bf_hi(rw.x) - mean) * rstd * g0.y + b0.y);
            const unsigned p1 = cvt_pk_bf16((bf_lo(rw.y) - mean) * rstd * g0.z + b0.z, (bf_hi(rw.y) - mean) * rstd * g0.w + b0.w);
            const unsigned p2 = cvt_pk_bf16((bf_lo(rw.z) - mean) * rstd * g1.x + b1.x, (bf_hi(rw.z) - mean) * rstd * g1.y + b1.y);
            const unsigned p3 = cvt_pk_bf16((bf_lo(rw.w) - mean) * rstd * g1.z + b1.z, (bf_hi(rw.w) - mean) * rstd * g1.w + b1.w);
            vp[0 * 136] = (bf16_t)(p0 & 0xffffu); vp[1 * 136] = (bf16_t)(p0 >> 16); vp[2 * 136] = (bf16_t)(p1 & 0xffffu); vp[3 * 136] = (bf16_t)(p1 >> 16);
            vp[4 * 136] = (bf16_t)(p2 & 0xffffu); vp[5 * 136] = (bf16_t)(p2 >> 16); vp[6 * 136] = (bf16_t)(p3 & 0xffffu); vp[7 * 136] = (bf16_t)(p3 >> 16);
        }
        __syncthreads();
        if (g < 3) {
#pragma unroll
            for (int cc = 0; cc < 4; ++cc) { const int c = tid + cc * 512, tk = c >> 4, ch = c & 15; raw[cc] = *(const GAS u32x4*)(Z + (size_t)(row0 + tk) * ZW + CVV + (g + 1) * 128 + ch * 8); }
        }
        f32x4 acc[8];
#pragma unroll
        for (int ct = 0; ct < 8; ++ct) acc[ct] = (f32x4){0.f, 0.f, 0.f, 0.f};
        const bf16_t* wrow = sgw + (size_t)(g * 128 + 16 * w + fr) * 128 + 8 * fq;
        const int nks = (w >> 1) + 1;
        for (int ks = 0; ks < nks; ++ks) {
            const bf16x8 bw = *(const GAS bf16x8*)(wrow + 32 * ks);
#pragma unroll
            for (int ct = 0; ct < 8; ++ct) {
                const bf16x8 av = *(const LAS bf16x8*)(Vt2 + (16 * ct + fr) * 136 + ((32 * ks + 8 * fq) ^ (((2 * ct + (fr >> 3)) & 15) << 3)));
                acc[ct] = __builtin_amdgcn_mfma_f32_16x16x32_bf16(av, bw, acc[ct], 0, 0, 0);
            }
        }
#pragma unroll
        for (int ct = 0; ct < 8; ++ct) {
            const u32x2 uv = uq[ct]; u32x2 wv;
            wv.x = cvt_pk_bf16(bf_lo(uv.x) * (acc[ct][0] + bias), bf_hi(uv.x) * (acc[ct][1] + bias));
            wv.y = cvt_pk_bf16(bf_lo(uv.y) * (acc[ct][2] + bias), bf_hi(uv.y) * (acc[ct][3] + bias));
            *(GAS u32x2*)(dry ? dummy + 16 * ct : up + 16 * ct) = wv;
        }
        __syncthreads();
        }
    }
}

DI void phase_final(const Ctx& C) {
    GAS float* out = (GAS float*)argp(C.lds, 21); const GAS bf16_t* hb = (const GAS bf16_t*)(C.ws + WS_HBB); const GAS float* ssqC = (const GAS float*)(C.ws + WS_SSQC); const GAS float* gf = (const GAS float*)argp(C.lds, 20);
    f32x4 g[4];
#pragma unroll
    for (int j = 0; j < 4; ++j) g[j] = ((const GAS f32x4*)gf + C.lane)[64 * j];
    for (int m0 = C.gw; m0 < MTOK; m0 += 4 * C.ngw) {
        u32x2 hv[4][4]; float sq[4];
#pragma unroll
        for (int k = 0; k < 4; ++k) { const int m = m0 + k * C.ngw; sq[k] = 0.f; if (m < MTOK) {
            sq[k] = (C.lane < 16) ? ssqC[(size_t)m * 16 + C.lane] : 0.f;
            const GAS u32x2* hr = (const GAS u32x2*)(hb + (size_t)m * DM) + C.lane;
#pragma unroll
            for (int j = 0; j < 4; ++j) hv[k][j] = hr[64 * j]; } }
#pragma unroll
        for (int k = 0; k < 4; ++k) { const int m = m0 + k * C.ngw; if (m < MTOK) {
            const float rs = 1.0f / sqrtf(wave_sum(sq[k]) * (1.0f / 1024.0f) + 1e-6f);
            GAS f32x4* orow = (GAS f32x4*)(out + (size_t)m * DM) + C.lane;
#pragma unroll
            for (int j = 0; j < 4; ++j) { const u32x2 h2 = hv[k][j];
                f32x4 v; v.x = bf_lo(h2.x) * rs * g[j].x; v.y = bf_hi(h2.x) * rs * g[j].y; v.z = bf_lo(h2.y) * rs * g[j].z; v.w = bf_hi(h2.y) * rs * g[j].w; orow[64 * j] = v; } } }
    }
}

#define XB_TMO      128
#define XB_XCNT(j)  (256  + 64 * (j))
#define XB_XSUB(j)  (1280 + 64 * (j))
#define XB_XGEN(j)  (2304 + 64 * (j))
#define XB_TOP      3328
#define XB_TOPGEN   3392
#define XCD_BAR_WORDS 3456
#define XB_SPIN_CAP (1u << 18)

__device__ __forceinline__ unsigned xb_ld(unsigned* p)              { return __hip_atomic_load(p, __ATOMIC_RELAXED, __HIP_MEMORY_SCOPE_AGENT); }
__device__ __forceinline__ unsigned xb_add(unsigned* p, unsigned v) { return __hip_atomic_fetch_add(p, v, __ATOMIC_RELAXED, __HIP_MEMORY_SCOPE_AGENT); }
__device__ __forceinline__ unsigned xb_xcc_id() { return (unsigned)__builtin_amdgcn_s_getreg((3 << 11) | 20) & 0xFu; }
#define XB_SPIN(cond, bar) do { unsigned _sp = 0; while (cond) { __builtin_amdgcn_s_sleep(1); \
    if ((++_sp & 255u) == 0u) { if (xb_ld(&(bar)[XB_TMO])) break; if (_sp > XB_SPIN_CAP) { atomicAdd(&(bar)[XB_TMO], 1u); break; } } } } while (0)

struct XcdBarrier {
    unsigned* bar; unsigned x;
    volatile LAS unsigned* st;
};

__device__ __forceinline__ XcdBarrier xcd_barrier_post(unsigned* bar, volatile LAS unsigned* st) {
    XcdBarrier b; b.bar = bar; b.x = xb_xcc_id(); b.st = st;
    if (threadIdx.x == 0) (void)xb_add(&bar[XB_XCNT(b.x)], 1u);
    return b;
}
__device__ __forceinline__ void xcd_barrier_complete(unsigned* bar, unsigned x, unsigned& nloc, unsigned& nx) {
    const unsigned G = gridDim.x * gridDim.y * gridDim.z;
    unsigned sum, cnt, mine, sp = 0u;
    for (;;) {
        sum = 0u; cnt = 0u; mine = 0u;
#pragma unroll
        for (unsigned j = 0; j < 16; ++j) { const unsigned c = xb_ld(&bar[XB_XCNT(j)]); sum += c; cnt += (c > 0u) ? 1u : 0u; mine = (j == x) ? c : mine; }
        if (sum == G) break;
        __builtin_amdgcn_s_sleep(1);
        if ((++sp & 255u) == 0u) { if (xb_ld(&bar[XB_TMO])) break; if (sp > XB_SPIN_CAP) { atomicAdd(&bar[XB_TMO], 1u); break; } }
    }
    nloc = mine > 0u ? mine : 1u; nx = cnt > 0u ? cnt : 1u;
}

__device__ __forceinline__ void xcd_barrier(const XcdBarrier& b) {
    asm volatile("s_waitcnt vmcnt(0)" ::: "memory");
    __syncthreads();
    if (threadIdx.x == 0) {
        unsigned* bar = b.bar;
        __builtin_amdgcn_s_waitcnt(0);
        unsigned nloc = b.st[0], nx = b.st[1];
        if (nloc == 0u) { xcd_barrier_complete(bar, b.x, nloc, nx); b.st[0] = nloc; b.st[1] = nx; }
        const unsigned old = xb_add(&bar[XB_XSUB(b.x)], 1u);
        const unsigned gen = old / nloc;
        if (old + 1u == (gen + 1u) * nloc) {
            __builtin_amdgcn_fence(__ATOMIC_RELEASE, "agent");
            asm volatile("s_waitcnt vmcnt(0)" ::: "memory");
            const unsigned og = xb_add(&bar[XB_TOP], 1u);
            const unsigned tg = og / nx;
            if (og + 1u == (tg + 1u) * nx) xb_add(&bar[XB_TOPGEN], 1u);
            else XB_SPIN(xb_ld(&bar[XB_TOPGEN]) == tg, bar);
            __builtin_amdgcn_fence(__ATOMIC_ACQUIRE, "agent");
            xb_add(&bar[XB_XGEN(b.x)], 1u);
            asm volatile("s_waitcnt vmcnt(0)" ::: "memory");
        } else {
            XB_SPIN(xb_ld(&bar[XB_XGEN(b.x)]) == gen, bar);
            __builtin_amdgcn_fence(__ATOMIC_ACQUIRE, "agent");
            asm volatile("s_waitcnt vmcnt(0)" ::: "memory");
        }
    }
    __syncthreads();
}

__global__ void __launch_bounds__(512) fwd_megakernel(Args args) {
    extern __shared__ __attribute__((aligned(16))) unsigned char lds_raw[];
    cg::grid_group grid = cg::this_grid();
    const int wave_s = __builtin_amdgcn_readfirstlane((int)threadIdx.x >> 6);
    {
        LAS unsigned long long* tb = (LAS unsigned long long*)((LAS unsigned char*)lds_raw + ARG_OFF);
        if (threadIdx.x < 21) tb[threadIdx.x] = (unsigned long long)args.in[threadIdx.x];
        if (threadIdx.x == 21) tb[21] = (unsigned long long)args.out;
        if (threadIdx.x == 22) tb[22] = (unsigned long long)args.ws;
        if (threadIdx.x >= 32 && threadIdx.x < 40) ((LAS float*)(tb + 23))[threadIdx.x - 32] = args.invf[threadIdx.x - 32];
        if (threadIdx.x == 64) { ((LAS unsigned*)((LAS unsigned char*)lds_raw + ARG_OFF + 256))[0] = 0u; ((LAS unsigned*)((LAS unsigned char*)lds_raw + ARG_OFF + 256))[1] = 0u; }
        __syncthreads();
    }
    if (args.ph_lo == 0 && blockIdx.x == 0) { unsigned* bw = (unsigned*)(args.ws + WS_BAR);
        for (int i = threadIdx.x; i < 4096; i += 512) __hip_atomic_store(bw + i, 0u, __ATOMIC_RELAXED, __HIP_MEMORY_SCOPE_AGENT); }
    int rep = 0;
    for (int ph = args.ph_lo; ph < args.ph_hi;) {
        int want = 1;
        const int tid_ = wave_s * 64 + lane_id_opaque();
        int bid_ = blockIdx.x, gsz_ = gridDim.x; asm volatile("" : "+s"(bid_), "+s"(gsz_));
        Ctx C; C.lds = (LAS unsigned char*)lds_raw; C.ws = nullptr; C.tid = tid_; C.lane = C.tid & 63; C.wave = wave_s;
        C.bid = bid_; C.gsz = gsz_;
        unsigned char* ws = (unsigned char*)argp(C.lds, 22); C.ws = ws;
        C.gw = C.bid * 8 + C.wave; C.ngw = C.gsz * 8;
        bf16_t* Z = (bf16_t*)(ws + WS_BIG); bf16_t* U = (bf16_t*)(ws + WS_BIG); bf16_t* PP = (bf16_t*)(ws + WS_PP);
        bf16_t* hbA = (bf16_t*)(ws + WS_HBA); bf16_t* hbB = (bf16_t*)(ws + WS_HBB);
        float* ssqA = (float*)(ws + WS_SSQA); float* ssqB = (float*)(ws + WS_SSQB); float* ssqC = (float*)(ws + WS_SSQC);
        float* lse = (float*)(ws + WS_LSE); float* rope = (float*)(ws + WS_ROPE);
        int njobs = 0, jtype = 0, L = 0;
        if (ph == 0) phase_prologue(C);
        else if (ph == NPHASE - 1) phase_final(C);
        else {
            L = (ph - 1) / 9; const int s = (ph - 1) % 9;
            if (s == 0) { phase_convert(C, L); want = 1 + PROBE_CVT; }
            else if (s == 1) { njobs = 1; jtype = 0; }
            else if (s == 2) { phase_attn(C, Z, lse, false); want = 1 + PROBE_ATTN; }
            else if (s == 3) { phase_mix(C, Z, lse, L, false); want = 1 + PROBE_MIX; }
            else if (s == 4) { njobs = 6; jtype = 1; }
            else if (s == 5) { njobs = 1; jtype = 2; }
            else if (s == 6) { njobs = 1; jtype = 3; }
            else if (s == 7) { njobs = 2; jtype = 4; }
            else { njobs = 1; jtype = 6; }
        }
        for (int ji = 0; ji < njobs; ++ji) {
            const int jt = jtype == 1 ? ((ji & 1) ? 1 : 0) : (jtype + ((jtype == 4) ? ji : 0));
            const bool gate_job = (jtype == 1);
            if (jt == 0) {
                const int b = ji >> 1;
                EpiIn E{gate_job ? (bf16_t*)(ws + WS_G) : Z, ssqC, rope, (bf16_t*)nullptr, gate_job ? DM : ZW, gate_job ? 4 : -1};
                want = gate_job ? 1 + PROBE_GATE : 1 + PROBE_IN + PROBE_INDRY;
                run_gemm(C.lds, C.bid, C.gsz, C.wave, hbB, DM, (const bf16_t*)(ws + WS_WIN) + (gate_job ? (size_t)(ZW + b * DM) * DM : 0), MTOK, gate_job ? DM : ZW, DM, E);
            } else if (jt == 1) {
                const int b = ji >> 1;
                const int ca = b == 0 ? CQ : (b == 1 ? CB : CU); const int kk = b == 0 ? 768 : 512;
                const bf16_t* bt = (const bf16_t*)(ws + (b == 0 ? WS_WBA : (b == 1 ? WS_WBB : WS_WBC)));
                EpiGate E{(const bf16_t*)(ws + WS_G), Z + CK, b > 0, (bf16_t*)nullptr}; want = 1 + PROBE_GATE; run_gemm(C.lds, C.bid, C.gsz, C.wave, Z + ca, ZW, bt, MTOK, DM, kk, E);
            } else if (jt == 2 || jt == 4) {
                const bool mix = (jt == 2);
                EpiRes E{mix ? hbB : hbA, hbA, mix ? ssqA : ssqB, (float*)nullptr};
                want = 1 + (mix ? PROBE_RESMIX : PROBE_DOWN);
                run_gemm(C.lds, C.bid, C.gsz, C.wave, mix ? Z + CK : U, mix ? ZW : UP, (const bf16_t*)(ws + (mix ? WS_WOUT3 : WS_WDOWN)), MTOK, DM, mix ? DM : DFF, E, mix ? DM : UP);
            } else if (jt == 3) { EpiUp E{U, ssqA}; want = 1 + PROBE_UP; run_gemm(C.lds, C.bid, C.gsz, C.wave, hbA, DM, (const bf16_t*)(ws + WS_WUP), MTOK, DFF, DM, E); }
            else if (jt == 5) { EpiPlain E{PP, DM}; run_gemm(C.lds, C.bid, C.gsz, C.wave, (const bf16_t*)(ws + WS_PBF), PLE, (const bf16_t*)(ws + WS_WPE), MTOK, DM, PLE, E); }
            else { EpiPle E{hbA, PP, ssqB, hbB, ssqC, (float*)nullptr}; want = 1 + PROBE_PLE; run_gemm(C.lds, C.bid, C.gsz, C.wave, hbA, DM, (const bf16_t*)(ws + WS_WPG), MTOK, DM, DM, E); }
        }
        if (++rep >= want) { rep = 0; ++ph; }
        if (ph < args.ph_hi) {
            if (ph == 1 && rep == 0) { grid.sync(); (void)xcd_barrier_post((unsigned*)(ws + WS_BAR), (volatile LAS unsigned*)(C.lds + ARG_OFF + 256)); }
            else {
                XcdBarrier xbar; xbar.bar = (unsigned*)(ws + WS_BAR); xbar.x = xb_xcc_id(); xbar.st = (volatile LAS unsigned*)(C.lds + ARG_OFF + 256);
                xcd_barrier(xbar); if (PROBE_SYNC) xcd_barrier(xbar);
            }
        }
    }
}

extern "C" void kernel_launch(void* const* d_in, const int* in_sizes, int n_in, void* d_out, int out_size, void* d_ws, size_t ws_size, hipStream_t stream) {
    static int grid = 0;
    if (grid == 0) {
        if (n_in != 21 || out_size != MTOK * DM || ws_size < WS_END) { fprintf(stderr, "kernel_launch: unexpected sizes (n_in %d out %d ws %zu)\n", n_in, out_size, ws_size); grid = -1; return; }
        int dev = 0, cus = 0, per_cu = 0;
        (void)hipGetDevice(&dev); (void)hipDeviceGetAttribute(&cus, hipDeviceAttributeMultiprocessorCount, dev);
        (void)hipFuncSetAttribute((const void*)fwd_megakernel, hipFuncAttributeMaxDynamicSharedMemorySize, LDS_BYTES);
        (void)hipOccupancyMaxActiveBlocksPerMultiprocessor(&per_cu, (const void*)fwd_megakernel, 512, LDS_BYTES);
        (void)hipGetLastError();
        if (per_cu < 1) per_cu = 1;
        grid = cus;
        if (grid <= 0) grid = 256;
    }
    if (grid < 0) return;
    Args a{};
    for (int i = 0; i < 21; ++i) a.in[i] = d_in[i];
    a.out = (float*)d_out; a.ws = (unsigned char*)d_ws;
    for (int j = 0; j < 8; ++j) a.invf[j] = (float)pow(500000.0, -(double)(2 * j) / 16.0);
#if MK_PER_PHASE_LAUNCH
    for (int ph = 0; ph < NPHASE; ++ph) { a.ph_lo = ph; a.ph_hi = ph + 1; hipLaunchKernelGGL(fwd_megakernel, dim3(grid), dim3(512), LDS_BYTES, stream, a); }
#else
    a.ph_lo = 0; a.ph_hi = NPHASE;
    void* kargs[] = {&a};
    hipError_t e = hipLaunchCooperativeKernel((const void*)fwd_megakernel, dim3(grid), dim3(512), kargs, LDS_BYTES, stream);
    if (e != hipSuccess) fprintf(stderr, "cooperative launch failed: %s (grid %d)\n", hipGetErrorString(e), grid);
#endif
}
```

```cpp
#include <hip/hip_runtime.h>
#include <hip/hip_cooperative_groups.h>
#include <cstdio>
#include <cstdint>
#include <cmath>
namespace cg = cooperative_groups;
#ifndef PROBE_ATTN
#define PROBE_ATTN 0
#endif
#ifndef PROBE_MIX
#define PROBE_MIX 0
#endif
#ifndef PROBE_CVT
#define PROBE_CVT 0
#endif
#ifndef PROBE_IN
#define PROBE_IN 0
#endif
#ifndef PROBE_UP
#define PROBE_UP 0
#endif
#ifndef PROBE_GATE
#define PROBE_GATE 0
#endif
#ifndef PROBE_RESMIX
#define PROBE_RESMIX 0
#endif
#ifndef PROBE_DOWN
#define PROBE_DOWN 0
#endif
#ifndef PROBE_PLE
#define PROBE_PLE 0
#endif
#ifndef PROBE_INDRY
#define PROBE_INDRY 0
#endif
#ifndef PROBE_SYNC
#define PROBE_SYNC 0
#endif
#ifndef MK_PER_PHASE_LAUNCH
#define MK_PER_PHASE_LAUNCH 0
#endif
__device__ __forceinline__ int lane_id_opaque();
namespace pg8 {
#define PG8_LAS __attribute__((address_space(3)))
typedef unsigned short bf16_t;
typedef short bf16x8 __attribute__((ext_vector_type(8)));
typedef float f32x4 __attribute__((ext_vector_type(4)));
typedef unsigned u32x4 __attribute__((ext_vector_type(4)));
constexpr int BM = 256, BK = 64, HALF = 128, HTB = HALF * BK * 2  , STAGE_BYTES = 8 * HTB, NXCD = 8, WGM = 4;

__host__ __device__ __forceinline__ int lds_byte(int r, int c) { const int st = (r >> 4) * 2 + (c >> 5), rr = r & 15, cc = c & 31, ob = rr * 64 + cc * 2; return st * 1024 + (ob ^ (((ob >> 9) & 1) << 5)); }
__host__ __device__ __forceinline__ void stage_rc(int b, int& R, int& C) { const int st = b / 1024, sb = b % 1024, swz = sb ^ (((sb >> 9) & 1) << 5); R = (st >> 1) * 16 + swz / 64; C = (st & 1) * 32 + (swz % 64) / 2; }
__host__ __device__ __forceinline__ int perm32(int rho) { const int n = rho >> 4, i = rho & 15; return 8 * (i >> 2) + 4 * n + (i & 3); }

struct Unit { int pm, pn; };
struct Gemm { const bf16_t* A; int lda; const bf16_t* Bt; int ldb; int M, N, K, wave; };

struct StaticOrder {
    int nM, nN, nwg, G, c;
    __host__ __device__ void init(int M, int N, int G_, int c_) { nM = M / BM; nN = N / BM; nwg = nM * nN; G = G_; c = c_; }
    __host__ __device__ bool next(int i, Unit& u) const {
        const long L = (long)i * G + c; if (L >= nwg) return false;
        int wgid = (int)L; { const int q = nwg / NXCD, r = nwg % NXCD, xcd = wgid % NXCD, off = wgid / NXCD; wgid = (xcd < r ? xcd * (q + 1) : r * (q + 1) + (xcd - r) * q) + off; }
        const int nig = WGM * nN, gid = wgid / nig, fm = gid * WGM, gsz = (nM - fm) < WGM ? (nM - fm) : WGM;
        u.pm = fm + ((wgid % nig) % gsz); u.pn = (wgid % nig) / gsz; return true;
    }
    __device__ __forceinline__ void a_ready(const Unit&) const {}
    __device__ __forceinline__ void done(const Unit&) const {}
};

__device__ __forceinline__ unsigned cvt_pk_bf16(float lo, float hi) { unsigned r; asm volatile("v_cvt_pk_bf16_f32 %0, %1, %2" : "=v"(r) : "v"(lo), "v"(hi)); return r; }
typedef float f32x2 __attribute__((ext_vector_type(2)));
__device__ __forceinline__ f32x2 gelu_pk(f32x2 v) {
    const f32x2 av = __builtin_elementwise_abs(v), d = av * 0.2316418882f + 1.0f;
    f32x2 t; t.x = __builtin_amdgcn_rcpf(d.x); t.y = __builtin_amdgcn_rcpf(d.y);
    f32x2 q = t * 0.5307027145f + (-0.7265760135f); q = q * t + 0.7107068705f; q = q * t + (-0.142248368f); q = q * t + 0.127414796f; q = q * t;
    const f32x2 s = (v * v) * (-0.72134752044f);
    f32x2 e; e.x = __builtin_amdgcn_exp2f(s.x); e.y = __builtin_amdgcn_exp2f(s.y);
    const f32x2 m = v * (q * e), r = v - m;
    f32x2 o; o.x = v.x < 0.f ? m.x : r.x; o.y = v.y < 0.f ? m.y : r.y; return o;
}
template <class Epi, class Sched, bool ALIGN_EPI = false, bool SP2 = false>
__device__ __forceinline__ void gemm_phase(PG8_LAS unsigned char* lds, const Gemm g, const Sched& S, const Epi& E) {
    const int tid = g.wave * 64 + lane_id_opaque(),
        wid = __builtin_amdgcn_readfirstlane(tid >> 6), lane = tid & 63, wr = wid >> 2, wc = wid & 3, fr = lane & 15, fq = lane >> 4;
    const int K = g.K, nt = K / BK;
    unsigned voffA[2], voffB[2];
#pragma unroll
    for (int i = 0; i < 2; ++i) { int R, C; stage_rc(tid * 16 + i * 8192, R, C); const int Rb = Epi::PERM ? ((R & ~31) + perm32(R & 31)) : R;
        voffA[i] = (unsigned)(R * g.lda + C) * 2u; voffB[i] = (unsigned)(Rb * g.ldb + C) * 2u; }
    const size_t kstep = (size_t)(BK * 2);
    const size_t hstepA = (size_t)HALF * g.lda * 2, hstepB = (size_t)HALF * g.ldb * 2;
    const size_t tstepA = 2 * hstepA, tstepB = 2 * hstepB;
    const unsigned ldsw = (unsigned)wid * 1024u;
    const int aoff = lds_byte(wr * 64 + fr, fq * 8), boff = lds_byte(wc * 32 + fr, fq * 8);
#define PG8_SA(b, h) (((b) * 2 + (h)) * HTB)
#define PG8_SB(b, h) ((4 + (b) * 2 + (h)) * HTB)
#define PG8_STAGE(bufoff, gbase, voff) do { _Pragma("unroll") for (int _i = 0; _i < 2; ++_i) \
        __builtin_amdgcn_global_load_lds((const unsigned*)((const char*)(gbase) + (voff)[_i]), (PG8_LAS unsigned*)(lds + (bufoff) + ldsw + _i * 8192), 16, 0, 0); } while (0)
#define PG8_LDA(dst, b, h) do { _Pragma("unroll") for (int m = 0; m < 4; ++m) _Pragma("unroll") for (int k = 0; k < 2; ++k) dst[m][k] = *(const PG8_LAS bf16x8*)(lds + PG8_SA(b, h) + aoff + m * 2048 + k * 1024); } while (0)
#define PG8_LDB(dst, b, h) do { _Pragma("unroll") for (int n = 0; n < 2; ++n) _Pragma("unroll") for (int k = 0; k < 2; ++k) dst[n][k] = *(const PG8_LAS bf16x8*)(lds + PG8_SB(b, h) + boff + n * 2048 + k * 1024); } while (0)
#define PG8_MMA(ai, bj, At, Bt) do { __builtin_amdgcn_s_setprio(1); _Pragma("unroll") for (int m = 0; m < 4; ++m) _Pragma("unroll") for (int n = 0; n < 2; ++n) _Pragma("unroll") for (int k = 0; k < 2; ++k) \
        acc[ai][bj][m][n] = __builtin_amdgcn_mfma_f32_16x16x32_bf16(Bt[n][k], At[m][k], acc[ai][bj][m][n], 0, 0, 0); __builtin_amdgcn_s_setprio(0); } while (0)
#define PG8_WAIT_V(n) asm volatile("s_waitcnt vmcnt(" #n ")" ::: "memory")
#define PG8_WAIT_L(n) asm volatile("s_waitcnt lgkmcnt(" #n ")" ::: "memory")
#define PG8_BAR __builtin_amdgcn_s_barrier()
#define PG8_SCHED __builtin_amdgcn_sched_barrier(0)
    Unit cur, nxt; int ui = 0;
    if (!S.next(0, cur)) return;
    f32x4 acc[2][2][4][2];
#pragma unroll
    for (int a = 0; a < 2; ++a)
#pragma unroll
        for (int b = 0; b < 2; ++b)
#pragma unroll
            for (int m = 0; m < 4; ++m)
#pragma unroll
                for (int n = 0; n < 2; ++n) acc[a][b][m][n] = (f32x4){0.f, 0.f, 0.f, 0.f};
    bf16x8 At[4][2], B0[2][2], B1[2][2];
    const char* cA = (const char*)g.A + (size_t)cur.pm * tstepA; const char* cB = (const char*)g.Bt + (size_t)cur.pn * tstepB;
    S.a_ready(cur);
    if constexpr (SP2) {
        PG8_STAGE(PG8_SB(0, 0), cB, voffB); PG8_STAGE(PG8_SB(0, 1), cB + hstepB, voffB); PG8_STAGE(PG8_SA(0, 0), cA, voffA); PG8_STAGE(PG8_SA(0, 1), cA + hstepA, voffA);
        if (wr == 1) PG8_BAR;
        PG8_WAIT_V(2); PG8_BAR;
        PG8_STAGE(PG8_SB(1, 0), cB + kstep, voffB); PG8_STAGE(PG8_SA(1, 0), cA + kstep, voffA); PG8_STAGE(PG8_SB(1, 1), cB + hstepB + kstep, voffB);
        PG8_WAIT_V(6); PG8_BAR;
    } else {
        PG8_STAGE(PG8_SB(0, 0), cB, voffB); PG8_STAGE(PG8_SA(0, 0), cA, voffA); PG8_STAGE(PG8_SB(0, 1), cB + hstepB, voffB); PG8_STAGE(PG8_SA(0, 1), cA + hstepA, voffA);
        if (wr == 1) PG8_BAR;
        PG8_WAIT_V(4); PG8_BAR;
        PG8_STAGE(PG8_SB(1, 0), cB + kstep, voffB); PG8_STAGE(PG8_SA(1, 0), cA + kstep, voffA); PG8_STAGE(PG8_SB(1, 1), cB + hstepB + kstep, voffB);
        PG8_WAIT_V(6); PG8_BAR;
    }
    for (;;) {
        const bool has_next = S.next(ui + 1, nxt);
        const char* nA = has_next ? (const char*)g.A + (size_t)nxt.pm * tstepA : cA; const char* nB = has_next ? (const char*)g.Bt + (size_t)nxt.pn * tstepB : cB;
        for (int t = 0; t < nt; t += 2) {
            const bool last = (t == nt - 2);
            const char* a1 = cA + (size_t)(t + 1) * kstep;
            const char* a2 = last ? nA : cA + (size_t)(t + 2) * kstep; const char* b2 = last ? nB : cB + (size_t)(t + 2) * kstep;
            const char* a3 = a2 + kstep; const char* b3 = b2 + kstep;
            if (last && has_next) S.a_ready(nxt);
            if constexpr (SP2) {
            PG8_LDB(B0, 0, 0); PG8_LDB(B1, 0, 1); PG8_SCHED; PG8_LDA(At, 0, 0); PG8_STAGE(PG8_SA(1, 1), a1 + hstepA, voffA);
            PG8_WAIT_V(8); PG8_WAIT_L(0); PG8_BAR; PG8_MMA(0, 0, At, B0); PG8_MMA(0, 1, At, B1); PG8_BAR; PG8_SCHED;
            PG8_LDA(At, 0, 1); PG8_STAGE(PG8_SB(0, 0), b2, voffB); PG8_STAGE(PG8_SB(0, 1), b2 + hstepB, voffB); PG8_STAGE(PG8_SA(0, 0), a2, voffA);
            PG8_WAIT_V(8); PG8_WAIT_L(0); PG8_BAR; PG8_MMA(1, 0, At, B0); PG8_MMA(1, 1, At, B1); PG8_BAR; PG8_SCHED;
            PG8_LDB(B0, 1, 0); PG8_LDB(B1, 1, 1); PG8_SCHED; PG8_LDA(At, 1, 0); PG8_STAGE(PG8_SA(0, 1), a2 + hstepA, voffA);
            PG8_WAIT_V(8); PG8_WAIT_L(0); PG8_BAR; PG8_MMA(0, 0, At, B0); PG8_MMA(0, 1, At, B1); PG8_BAR; PG8_SCHED;
            PG8_LDA(At, 1, 1); PG8_STAGE(PG8_SB(1, 0), b3, voffB); PG8_STAGE(PG8_SB(1, 1), b3 + hstepB, voffB); PG8_STAGE(PG8_SA(1, 0), a3, voffA);
            PG8_WAIT_V(8); PG8_WAIT_L(0); PG8_BAR; PG8_MMA(1, 0, At, B0); PG8_MMA(1, 1, At, B1); PG8_BAR; PG8_SCHED;
            } else {
            PG8_LDB(B0, 0, 0); PG8_SCHED; PG8_LDA(At, 0, 0); PG8_STAGE(PG8_SA(1, 1), a1 + hstepA, voffA);
            PG8_WAIT_L(8); PG8_BAR; PG8_WAIT_L(0); PG8_MMA(0, 0, At, B0); PG8_BAR; PG8_SCHED;
            PG8_LDB(B1, 0, 1); PG8_STAGE(PG8_SB(0, 0), b2, voffB);
            PG8_BAR; PG8_WAIT_L(0); PG8_MMA(0, 1, At, B1); PG8_BAR;
            PG8_LDA(At, 0, 1); PG8_STAGE(PG8_SA(0, 0), a2, voffA);
            PG8_BAR; PG8_WAIT_L(0); PG8_MMA(1, 0, At, B0); PG8_BAR; PG8_SCHED;
            PG8_STAGE(PG8_SB(0, 1), b2 + hstepB, voffB);
            PG8_WAIT_V(6); PG8_BAR; PG8_MMA(1, 1, At, B1); PG8_BAR;
            PG8_LDB(B0, 1, 0); PG8_SCHED; PG8_LDA(At, 1, 0); PG8_STAGE(PG8_SA(0, 1), a2 + hstepA, voffA);
            PG8_WAIT_L(8); PG8_BAR; PG8_WAIT_L(0); PG8_MMA(0, 0, At, B0); PG8_BAR; PG8_SCHED;
            PG8_LDB(B1, 1, 1); PG8_STAGE(PG8_SB(1, 0), b3, voffB);
            PG8_BAR; PG8_WAIT_L(0); PG8_MMA(0, 1, At, B1); PG8_BAR;
            PG8_LDA(At, 1, 1); PG8_STAGE(PG8_SA(1, 0), a3, voffA);
            PG8_BAR; PG8_WAIT_L(0); PG8_MMA(1, 0, At, B0); PG8_BAR; PG8_SCHED;
            PG8_STAGE(PG8_SB(1, 1), b3 + hstepB, voffB);
            PG8_WAIT_V(6); PG8_BAR; PG8_MMA(1, 1, At, B1); PG8_BAR;
            }
        }
        if constexpr (ALIGN_EPI) { if (wr == 0) PG8_BAR; }
        if constexpr (!Epi::AFTER_DRAIN) { E(acc, cur, wr, wc, fr, fq); S.done(cur); }
        if (!has_next) break;
#pragma unroll
        for (int a = 0; a < 2; ++a)
#pragma unroll
            for (int b = 0; b < 2; ++b)
#pragma unroll
                for (int m = 0; m < 4; ++m)
#pragma unroll
                    for (int n = 0; n < 2; ++n) acc[a][b][m][n] = (f32x4){0.f, 0.f, 0.f, 0.f};
        cur = nxt; cA = nA; cB = nB; ++ui;
        if constexpr (ALIGN_EPI) { if (wr == 1) PG8_BAR; }
    }
    PG8_WAIT_V(0);
    if constexpr (!ALIGN_EPI) { if (wr == 0) PG8_BAR; }
    PG8_BAR;
    if constexpr (Epi::AFTER_DRAIN) { E.fused(acc, cur, wr, wc, fr, fq, lds, wid, lane); S.done(cur); }
#undef PG8_SA
#undef PG8_SB
#undef PG8_STAGE
#undef PG8_LDA
#undef PG8_LDB
#undef PG8_MMA
#undef PG8_WAIT_V
#undef PG8_WAIT_L
#undef PG8_BAR
#undef PG8_SCHED
}
}

#define DI __device__ __forceinline__
#define LAS __attribute__((address_space(3)))
#define GAS __attribute__((address_space(1)))
typedef unsigned short bf16_t;
typedef float f32x4 __attribute__((ext_vector_type(4)));
typedef float f32x2 __attribute__((ext_vector_type(2)));
typedef unsigned u32x4 __attribute__((ext_vector_type(4)));
typedef unsigned u32x2 __attribute__((ext_vector_type(2)));
typedef short bf16x8 __attribute__((ext_vector_type(8)));
typedef short s16x4 __attribute__((ext_vector_type(4)));

constexpr int DM = 1024, SEQ = 4096, NLAYER = 4, MTOK = 32768, MH = 16384, INW = 7936, DFF = 4096, PLE = 256;
constexpr int UP = 4160;
constexpr int ZW = 4864;
constexpr int CQ = 0, CK = 768, CV = 1536, CX = 2304, CB = 2816, CC = 3328, CU = 3840, CVV = 4352, CG = 4864;
constexpr size_t MiB = 1u << 20;
constexpr size_t WS_ROPE = 0, WS_SSQA = 2 * MiB, WS_SSQB = 4 * MiB, WS_SSQC = 6 * MiB, WS_LSE = 8 * MiB, WS_DUMMY = 9 * MiB + 524288, WS_BAR = 9 * MiB + 655360, WS_SGW = 9 * MiB + 786432,
                 WS_WIN = 10 * MiB, WS_WBA = 26 * MiB, WS_WBB = 28 * MiB, WS_WBC = 29 * MiB, WS_WOUT3 = 30 * MiB, WS_WUP = 36 * MiB,
                 WS_WDOWN = 44 * MiB, WS_WPG = 53 * MiB, WS_WPE = 55 * MiB, WS_PBF = 56 * MiB, WS_HBA = 72 * MiB, WS_HBB = 136 * MiB,
                 WS_BIG = 200 * MiB, WS_PP = 460 * MiB, WS_G = 504 * MiB, WS_END = 568 * MiB;
constexpr int LDS_BYTES = 147456;
constexpr int NPHASE = 2 + NLAYER * 9;

struct Args { const void* in[21]; float* out; unsigned char* ws; float invf[8]; int ph_lo, ph_hi; };

using pg8::cvt_pk_bf16;
DI float bf_lo(unsigned w) { return __uint_as_float(w << 16); }
DI float bf_hi(unsigned w) { return __uint_as_float(w & 0xffff0000u); }
DI int lane_id_opaque() { int l; asm volatile("v_mbcnt_lo_u32_b32 %0, -1, 0\n\tv_mbcnt_hi_u32_b32 %0, -1, %0" : "=v"(l)); return l; }
template <int X> DI float lane_xor(float v) {
    return __int_as_float(__builtin_amdgcn_ds_swizzle(__float_as_int(v), (X << 10) | 0x1f));
}
DI float sum_xor32(float v) { auto rr = __builtin_amdgcn_permlane32_swap(__float_as_uint(v), __float_as_uint(v), false, false); return __uint_as_float(rr[0]) + __uint_as_float(rr[1]); }
DI float max_xor32(float v) { auto rr = __builtin_amdgcn_permlane32_swap(__float_as_uint(v), __float_as_uint(v), false, false); return fmaxf(__uint_as_float(rr[0]), __uint_as_float(rr[1])); }
DI float wave_sum(float v) {
    v += lane_xor<1>(v); v += lane_xor<2>(v); v += lane_xor<4>(v); v += lane_xor<8>(v); v += lane_xor<16>(v);
    return sum_xor32(v);
}
DI float sigmoidf_fast(float x) { return __builtin_amdgcn_rcpf(1.0f + __builtin_amdgcn_exp2f(-1.4426950408889634f * x)); }
DI float row_rstd(const float* ssq, int row, int fq) {
    const f32x4 v = *(const GAS f32x4*)(ssq + (size_t)row * 16 + 4 * fq);
    float s = (v.x + v.y) + (v.z + v.w);
    s += lane_xor<16>(s); s = sum_xor32(s);
    return 1.0f / sqrtf(s * (1.0f / 1024.0f) + 1e-6f);
}

typedef const f32x4 (&AccRef)[2][2][4][2];
#define EPI_ROWS_BEGIN _Pragma("unroll") for (int ai = 0; ai < 2; ++ai) _Pragma("unroll") for (int m = 0; m < 4; ++m) { const int lrow = u.pm * 256 + ai * 128 + wr * 64 + m * 16 + fr;
#define EPI_COLS_BEGIN _Pragma("unroll") for (int bj = 0; bj < 2; ++bj) { const int col = u.pn * 256 + bj * 128 + wc * 32 + 8 * fq; f32x4 v0 = acc[ai][bj][m][0], v1 = acc[ai][bj][m][1];
#define EPI_END }
#define EPI_ROW_END }
#define EPI_PRELOAD_RSTD(ssqptr) float rs8[8]; { f32x4 q8_[8]; \
    _Pragma("unroll") for (int ai = 0; ai < 2; ++ai) _Pragma("unroll") for (int m = 0; m < 4; ++m) q8_[ai * 4 + m] = *(const GAS f32x4*)((ssqptr) + (size_t)(u.pm * 256 + ai * 128 + wr * 64 + m * 16 + fr) * 16 + 4 * fq); \
    asm volatile("" ::: "memory");     \
    _Pragma("unroll") for (int i_ = 0; i_ < 8; ++i_) { float s_ = (q8_[i_].x + q8_[i_].y) + (q8_[i_].z + q8_[i_].w); s_ += lane_xor<16>(s_); s_ = sum_xor32(s_); rs8[i_] = 1.0f / sqrtf(s_ * (1.0f / 1024.0f) + 1e-6f); } } \
    asm volatile("" ::: "memory");

struct EpiIn {
    static constexpr bool PERM = true, AFTER_DRAIN = false;
    bf16_t* Z; const float* ssq; const float* rope; bf16_t* dummy; int ldz, kind_force;
    DI void operator()(AccRef acc, const pg8::Unit& u, int wr, int wc, int, int) const {
        const int lane_ = lane_id_opaque(), fr = lane_ & 15, fq = lane_ >> 4;
        const int pn = u.pn;
        const int kind = dummy ? 2 : (kind_force >= 0 ? kind_force : (pn < 6 ? (pn < 3 ? 0 : 1) : (pn < 15 ? 2 : (pn < 19 ? 3 : 4))));
        const bool rot = (kind < 2) && ((wc & 1) == 0);
        const float qs = (kind == 0) ? 0.125f : 1.0f;
        EPI_PRELOAD_RSTD(ssq)
#pragma unroll
        for (int ai = 0; ai < 2; ++ai) {
        f32x4 rc0[4], rc1[4], rs0[4], rs1[4];
#pragma unroll
        for (int m = 0; m < 4; ++m) { rc0[m] = (f32x4){1.f, 1.f, 1.f, 1.f}; rc1[m] = rc0[m]; rs0[m] = (f32x4){0.f, 0.f, 0.f, 0.f}; rs1[m] = rs0[m]; }
        if (rot) {
#pragma unroll
            for (int m = 0; m < 4; ++m) { const GAS f32x4* rp = (const GAS f32x4*)(rope + (size_t)(u.pm * 256 + ai * 128 + wr * 64 + m * 16 + fr) * 16); rc0[m] = rp[0]; rc1[m] = rp[1]; rs0[m] = rp[2]; rs1[m] = rp[3]; }
        }
        asm volatile("" ::: "memory");
#pragma unroll
        for (int m = 0; m < 4; ++m) { const int lrow = u.pm * 256 + ai * 128 + wr * 64 + m * 16 + fr;
            const float rs = rs8[ai * 4 + m];
            const f32x4 c0 = rc0[m], c1 = rc1[m], s0 = rs0[m], s1 = rs1[m];
            EPI_COLS_BEGIN
                v0 = v0 * rs; v1 = v1 * rs;
                if (kind < 2) {
                    if (rot) {
                        f32x4 p0, p1;
#pragma unroll
                        for (int e = 0; e < 4; ++e) { p0[e] = lane_xor<16>(v0[e]); p1[e] = lane_xor<16>(v1[e]); }
                        if (fq == 0) { v0 = v0 * c0 - p0 * s0; v1 = v1 * c1 - p1 * s1; }
                        else if (fq == 1) { v0 = v0 * c0 + p0 * s0; v1 = v1 * c1 + p1 * s1; }
                    }
                    v0 = v0 * qs; v1 = v1 * qs;
                } else if (kind == 3) {
                    f32x2 a = pg8::gelu_pk((f32x2){v0[0], v0[1]}), b = pg8::gelu_pk((f32x2){v0[2], v0[3]}), c = pg8::gelu_pk((f32x2){v1[0], v1[1]}), d = pg8::gelu_pk((f32x2){v1[2], v1[3]});
                    v0 = (f32x4){a.x, a.y, b.x, b.y}; v1 = (f32x4){c.x, c.y, d.x, d.y};
                } else if (kind == 4) {
#pragma unroll
                    for (int e = 0; e < 4; ++e) { v0[e] = sigmoidf_fast(v0[e]); v1[e] = sigmoidf_fast(v1[e]); }
                }
                u32x4 w; w.x = cvt_pk_bf16(v0[0], v0[1]); w.y = cvt_pk_bf16(v0[2], v0[3]); w.z = cvt_pk_bf16(v1[0], v1[1]); w.w = cvt_pk_bf16(v1[2], v1[3]);
                *(GAS u32x4*)(dummy ? dummy + lane_ * 8 : Z + (size_t)lrow * ldz + col) = w;
            EPI_END
        }
        }
    }
};
struct EpiGate {
    static constexpr bool PERM = true, AFTER_DRAIN = false, HAS_LOADS = true;
    const bf16_t* G; bf16_t* Mo; int has_prev; bf16_t* dummy;
    DI void operator()(AccRef acc, const pg8::Unit& u, int wr, int wc, int, int) const {
        const int lane_ = lane_id_opaque(), fr = lane_ & 15, fq = lane_ >> 4;
#pragma unroll
        for (int ai = 0; ai < 2; ++ai) {
            u32x4 gq[4][2], pq[4][2];
#pragma unroll
            for (int m = 0; m < 4; ++m)
#pragma unroll
                for (int bj = 0; bj < 2; ++bj) {
                    const int lrow = u.pm * 256 + ai * 128 + wr * 64 + m * 16 + fr, col = u.pn * 256 + bj * 128 + wc * 32 + 8 * fq;
                    gq[m][bj] = *(const GAS u32x4*)(G + (size_t)lrow * DM + col);
                    pq[m][bj] = (u32x4){0u, 0u, 0u, 0u};
                    if (has_prev) pq[m][bj] = *(const GAS u32x4*)(Mo + (size_t)lrow * ZW + col);
                }
            asm volatile("" ::: "memory");
#pragma unroll
            for (int m = 0; m < 4; ++m) {
                const int lrow = u.pm * 256 + ai * 128 + wr * 64 + m * 16 + fr;
                EPI_COLS_BEGIN
                    const size_t off = (size_t)lrow * ZW + col;
                    const u32x4 g = gq[m][bj], p = pq[m][bj];
                    v0[0] = v0[0] * bf_lo(g.x) + bf_lo(p.x); v0[1] = v0[1] * bf_hi(g.x) + bf_hi(p.x); v0[2] = v0[2] * bf_lo(g.y) + bf_lo(p.y); v0[3] = v0[3] * bf_hi(g.y) + bf_hi(p.y);
                    v1[0] = v1[0] * bf_lo(g.z) + bf_lo(p.z); v1[1] = v1[1] * bf_hi(g.z) + bf_hi(p.z); v1[2] = v1[2] * bf_lo(g.w) + bf_lo(p.w); v1[3] = v1[3] * bf_hi(g.w) + bf_hi(p.w);
                    u32x4 w; w.x = cvt_pk_bf16(v0[0], v0[1]); w.y = cvt_pk_bf16(v0[2], v0[3]); w.z = cvt_pk_bf16(v1[0], v1[1]); w.w = cvt_pk_bf16(v1[2], v1[3]);
                    *(GAS u32x4*)(dummy ? dummy + lane_ * 8 : Mo + off) = w;
                EPI_END
            }
        }
    }
};
struct EpiRes {
    static constexpr bool PERM = true, AFTER_DRAIN = false, HAS_LOADS = true;
    const bf16_t* Hin; bf16_t* Hout; float* ssq_out; float* dummy;
    DI void operator()(AccRef acc, const pg8::Unit& u, int wr, int wc, int, int) const {
        const int lane_ = lane_id_opaque(), fr = lane_ & 15, fq = lane_ >> 4;
        u32x4 hv[2][4][2];
#pragma unroll
        for (int ai = 0; ai < 2; ++ai)
#pragma unroll
            for (int m = 0; m < 4; ++m)
#pragma unroll
                for (int bj = 0; bj < 2; ++bj)
                    hv[ai][m][bj] = *(const GAS u32x4*)(Hin + (size_t)(u.pm * 256 + ai * 128 + wr * 64 + m * 16 + fr) * DM + u.pn * 256 + bj * 128 + wc * 32 + 8 * fq);
        asm volatile("" ::: "memory");
        EPI_ROWS_BEGIN
            float ss = 0.f;
            EPI_COLS_BEGIN
                const size_t off = (size_t)lrow * DM + col;
                const u32x4 h4 = hv[ai][m][bj];
                v0[0] += bf_lo(h4.x); v0[1] += bf_hi(h4.x); v0[2] += bf_lo(h4.y); v0[3] += bf_hi(h4.y);
                v1[0] += bf_lo(h4.z); v1[1] += bf_hi(h4.z); v1[2] += bf_lo(h4.w); v1[3] += bf_hi(h4.w);
                ss += (v0[0] * v0[0] + v0[1] * v0[1]) + (v0[2] * v0[2] + v0[3] * v0[3]) + (v1[0] * v1[0] + v1[1] * v1[1]) + (v1[2] * v1[2] + v1[3] * v1[3]);
                u32x4 w; w.x = cvt_pk_bf16(v0[0], v0[1]); w.y = cvt_pk_bf16(v0[2], v0[3]); w.z = cvt_pk_bf16(v1[0], v1[1]); w.w = cvt_pk_bf16(v1[2], v1[3]);
                *(GAS u32x4*)(dummy ? (bf16_t*)(dummy + 2048) + lane_ * 8 : Hout + off) = w;
            EPI_END
            ss += lane_xor<16>(ss); ss = sum_xor32(ss);
            if (fq == 0) *(GAS float*)(dummy ? dummy + 4096 + lane_ : ssq_out + (size_t)lrow * 16 + u.pn * 4 + wc) = ss;
        EPI_ROW_END
    }
};
struct EpiUp {
    static constexpr bool PERM = true, AFTER_DRAIN = false;
    bf16_t* U; const float* ssq;
    DI void operator()(AccRef acc, const pg8::Unit& u, int wr, int wc, int, int) const {
        const int lane_ = lane_id_opaque(), fr = lane_ & 15, fq = lane_ >> 4;
        EPI_PRELOAD_RSTD(ssq)
        EPI_ROWS_BEGIN
            const float rs = rs8[ai * 4 + m];
            EPI_COLS_BEGIN
#pragma unroll
                for (int e = 0; e < 4; ++e) { float a = fmaxf(v0[e] * rs, 0.f), b = fmaxf(v1[e] * rs, 0.f); v0[e] = a * a; v1[e] = b * b; }
                u32x4 w; w.x = cvt_pk_bf16(v0[0], v0[1]); w.y = cvt_pk_bf16(v0[2], v0[3]); w.z = cvt_pk_bf16(v1[0], v1[1]); w.w = cvt_pk_bf16(v1[2], v1[3]);
                *(GAS u32x4*)(U + (size_t)lrow * UP + col) = w;
            EPI_END
        EPI_ROW_END
    }
};
struct EpiPlain {
    static constexpr bool PERM = true, AFTER_DRAIN = false;
    bf16_t* O; int ldc;
    DI void operator()(AccRef acc, const pg8::Unit& u, int wr, int wc, int, int) const {
        const int lane_ = lane_id_opaque(), fr = lane_ & 15, fq = lane_ >> 4;
        EPI_ROWS_BEGIN
            EPI_COLS_BEGIN
                u32x4 w; w.x = cvt_pk_bf16(v0[0], v0[1]); w.y = cvt_pk_bf16(v0[2], v0[3]); w.z = cvt_pk_bf16(v1[0], v1[1]); w.w = cvt_pk_bf16(v1[2], v1[3]);
                *(GAS u32x4*)(O + (size_t)lrow * ldc + col) = w;
            EPI_END
        EPI_ROW_END
    }
};
struct EpiPle {
    static constexpr bool PERM = true, AFTER_DRAIN = false, HAS_LOADS = true;
    const bf16_t* Hin; const bf16_t* PP; const float* ssq; bf16_t* Hout; float* ssq_out; float* dummy;
    DI void operator()(AccRef acc, const pg8::Unit& u, int wr, int wc, int, int) const {
        const int lane_ = lane_id_opaque(), fr = lane_ & 15, fq = lane_ >> 4;
        EPI_PRELOAD_RSTD(ssq)
#pragma unroll
        for (int ai = 0; ai < 2; ++ai) {
            u32x4 hq[4][2];
#pragma unroll
            for (int m = 0; m < 4; ++m)
#pragma unroll
                for (int bj = 0; bj < 2; ++bj)
                    hq[m][bj] = *(const GAS u32x4*)(Hin + (size_t)(u.pm * 256 + ai * 128 + wr * 64 + m * 16 + fr) * DM + u.pn * 256 + bj * 128 + wc * 32 + 8 * fq);
            asm volatile("" ::: "memory");
#pragma unroll
            for (int mp = 0; mp < 2; ++mp) {
                u32x4 gq[2][2];
#pragma unroll
                for (int mm = 0; mm < 2; ++mm)
#pragma unroll
                    for (int bj = 0; bj < 2; ++bj)
                        gq[mm][bj] = *(const GAS u32x4*)(PP + (size_t)(u.pm * 256 + ai * 128 + wr * 64 + (2 * mp + mm) * 16 + fr) * DM + u.pn * 256 + bj * 128 + wc * 32 + 8 * fq);
                asm volatile("" ::: "memory");
#pragma unroll
                for (int mm = 0; mm < 2; ++mm) {
                    const int m = 2 * mp + mm;
                    const int lrow = u.pm * 256 + ai * 128 + wr * 64 + m * 16 + fr;
                    const float rs = rs8[ai * 4 + m];
                    float ss = 0.f;
                    EPI_COLS_BEGIN
                        const size_t off = (size_t)lrow * DM + col;
                        const u32x4 g = gq[mm][bj], hv = hq[m][bj];
                        v0[0] = bf_lo(hv.x) + sigmoidf_fast(v0[0] * rs) * bf_lo(g.x); v0[1] = bf_hi(hv.x) + sigmoidf_fast(v0[1] * rs) * bf_hi(g.x);
                        v0[2] = bf_lo(hv.y) + sigmoidf_fast(v0[2] * rs) * bf_lo(g.y); v0[3] = bf_hi(hv.y) + sigmoidf_fast(v0[3] * rs) * bf_hi(g.y);
                        v1[0] = bf_lo(hv.z) + sigmoidf_fast(v1[0] * rs) * bf_lo(g.z); v1[1] = bf_hi(hv.z) + sigmoidf_fast(v1[1] * rs) * bf_hi(g.z);
                        v1[2] = bf_lo(hv.w) + sigmoidf_fast(v1[2] * rs) * bf_lo(g.w); v1[3] = bf_hi(hv.w) + sigmoidf_fast(v1[3] * rs) * bf_hi(g.w);
                        ss += (v0[0] * v0[0] + v0[1] * v0[1]) + (v0[2] * v0[2] + v0[3] * v0[3]) + (v1[0] * v1[0] + v1[1] * v1[1]) + (v1[2] * v1[2] + v1[3] * v1[3]);
                        u32x4 w; w.x = cvt_pk_bf16(v0[0], v0[1]); w.y = cvt_pk_bf16(v0[2], v0[3]); w.z = cvt_pk_bf16(v1[0], v1[1]); w.w = cvt_pk_bf16(v1[2], v1[3]);
                        *(GAS u32x4*)(dummy ? (bf16_t*)(dummy + 2048) + lane_ * 8 : Hout + off) = w;
                    EPI_END
                    ss += lane_xor<16>(ss); ss = sum_xor32(ss);
                    if (fq == 0) *(GAS float*)(dummy ? dummy + 4096 + lane_ : ssq_out + (size_t)lrow * 16 + u.pn * 4 + wc) = ss;
                }
            }
        }
    }
};

template <class Epi>
DI void run_gemm(LAS unsigned char* lds, int bid, int gsz, int wave, const bf16_t* A, int lda, const bf16_t* Bt, int M, int N, int K, const Epi& E, int ldb = 0) {
    if (ldb == 0) ldb = K;
    pg8::Gemm g{A, lda, Bt, ldb, M, N, K, wave};
    pg8::StaticOrder S; S.init(M, N, gsz, bid);
    pg8::gemm_phase<Epi, pg8::StaticOrder, true, true>(lds, g, S, E);
}

DI void transpose_item(const float* W_, int K, int N, bf16_t* WT, int ldk, int koff, const float* gk_, LAS float* scr, int item, int lane) {
    const GAS float* W = (const GAS float*)W_; const GAS float* gk = (const GAS float*)gk_;
    const int nblk = N / 32, kb = item / nblk, nb = item % nblk, k0 = 64 * kb, n0 = 32 * nb;
    float wv_[32];
#pragma unroll
    for (int i = 0; i < 32; ++i) wv_[i] = __builtin_nontemporal_load(W + (size_t)(k0 + 2 * i + (lane >> 5)) * N + n0 + (lane & 31));
#pragma unroll
    for (int i = 0; i < 32; ++i) { const int kk = 2 * i + (lane >> 5); float v = wv_[i]; if (gk) v *= gk[k0 + kk]; scr[kk * 33 + (lane & 31)] = v; }
    asm volatile("s_waitcnt lgkmcnt(0)" ::: "memory");
    const int c = lane & 7;
#pragma unroll
    for (int j = 0; j < 4; ++j) { const int n = (lane >> 3) + 8 * j; const LAS float* s = scr + (8 * c) * 33 + n;
        u32x4 o; o.x = cvt_pk_bf16(s[0 * 33], s[1 * 33]); o.y = cvt_pk_bf16(s[2 * 33], s[3 * 33]); o.z = cvt_pk_bf16(s[4 * 33], s[5 * 33]); o.w = cvt_pk_bf16(s[6 * 33], s[7 * 33]);
        *(GAS u32x4*)(WT + (size_t)(n0 + n) * ldk + koff + k0 + 8 * c) = o; }
    asm volatile("s_waitcnt lgkmcnt(0)" ::: "memory");
}

constexpr int ARG_OFF = 131072;
DI const void* argp(LAS unsigned char* lds, int k) {
    unsigned a_ = ARG_OFF; asm volatile("" : "+s"(a_));
    const unsigned long long v = ((const LAS unsigned long long*)(lds + a_))[k];
    const unsigned lo = __builtin_amdgcn_readfirstlane((unsigned)v), hi = __builtin_amdgcn_readfirstlane((unsigned)(v >> 32));
    return (const void*)(((unsigned long long)hi << 32) | lo);
}
struct Ctx {
    LAS unsigned char* lds; unsigned char* ws; int tid, lane, wave, gw, ngw, bid, gsz;
};

DI void phase_prologue(const Ctx& C) {
    const GAS float* x = (const GAS float*)argp(C.lds, 0); const GAS int* pos = (const GAS int*)argp(C.lds, 2);
    GAS bf16_t* hbB = (GAS bf16_t*)(C.ws + WS_HBB); GAS float* ssqC = (GAS float*)(C.ws + WS_SSQC); GAS float* rope = (GAS float*)(C.ws + WS_ROPE);
    for (int m0 = C.gw; m0 < MTOK; m0 += 4 * C.ngw) {
        f32x4 v[4][4];
#pragma unroll
        for (int k = 0; k < 4; ++k) { const int m = m0 + k * C.ngw; if (m < MTOK) { const GAS f32x4* xr = (const GAS f32x4*)(x + (size_t)m * DM) + C.lane;
#pragma unroll
            for (int j = 0; j < 4; ++j) v[k][j] = __builtin_nontemporal_load(xr + 64 * j); } }
#pragma unroll
        for (int k = 0; k < 4; ++k) { const int m = m0 + k * C.ngw; if (m < MTOK) {
            GAS u32x2* br = (GAS u32x2*)(hbB + (size_t)m * DM) + C.lane; float s = 0.f;
#pragma unroll
            for (int j = 0; j < 4; ++j) { const f32x4 t = v[k][j]; s += (t.x * t.x + t.y * t.y) + (t.z * t.z + t.w * t.w);
                u32x2 w; w.x = cvt_pk_bf16(t.x, t.y); w.y = cvt_pk_bf16(t.z, t.w); br[64 * j] = w; }
            s = wave_sum(s);
            if (C.lane < 16) ssqC[(size_t)m * 16 + C.lane] = (C.lane == 0) ? s : 0.f; } }
    }
    const int gt = C.gw * 64 + C.lane, ngt = C.ngw * 64;
    for (int tok = gt; tok < MTOK; tok += ngt) {
        const float pf = (float)pos[tok];
#pragma unroll
        for (int j = 0; j < 8; ++j) {
            const float ang = __fmul_rn(pf, ((const LAS float*)(C.lds + ARG_OFF + 23 * 8))[j]);
            const double rev = (double)ang * 0.15915494309189535; const float frc = (float)(rev - __builtin_rint(rev));
            rope[(size_t)tok * 16 + j] = __builtin_amdgcn_cosf(frc); rope[(size_t)tok * 16 + 8 + j] = __builtin_amdgcn_sinf(frc);
        }
    }
}

DI void phase_convert(const Ctx& C, int L) {
    LAS float* scr = (LAS float*)(C.lds + C.wave * 16384);
    const float* w_in = (const float*)argp(C.lds, 4) + (size_t)L * DM * INW; const float* g_mix = (const float*)argp(C.lds, 3) + L * DM;
    const float* w_ba = (const float*)argp(C.lds, 10) + (size_t)L * 768 * DM; const float* w_bb = (const float*)argp(C.lds, 11) + (size_t)L * 512 * DM; const float* w_bc = (const float*)argp(C.lds, 12) + (size_t)L * 512 * DM;
    const float* w_out = (const float*)argp(C.lds, 13) + (size_t)L * DM * DM;
    const float* w_up = (const float*)argp(C.lds, 15) + (size_t)L * DM * DFF; const float* g_mlp = (const float*)argp(C.lds, 14) + L * DM;
    const float* w_down = (const float*)argp(C.lds, 16) + (size_t)L * DFF * DM;
    const float* w_pg = (const float*)argp(C.lds, 18) + (size_t)L * DM * DM; const float* g_ple = (const float*)argp(C.lds, 17) + L * DM;
    const float* w_pe = (const float*)argp(C.lds, 19) + (size_t)L * PLE * DM;
    constexpr int I_IN = 16 * (INW / 32), I_BA = 12 * 32, I_BB = 8 * 32, I_OUT = 16 * 32, I_UP = 16 * (DFF / 32), I_DOWN = 64 * 32, I_PG = 16 * 32, I_PE = 4 * 32;
    constexpr int NITEMS = I_IN + I_BA + 2 * I_BB + I_OUT + I_UP + I_DOWN + I_PG + I_PE;
    for (int it = C.gw; it < NITEMS; it += C.ngw) {
        int r = it;
        if (r < I_IN) { transpose_item(w_in, DM, INW, (bf16_t*)(C.ws + WS_WIN), DM, 0, g_mix, scr, r, C.lane); continue; } r -= I_IN;
        if (r < I_BA) { transpose_item(w_ba, 768, DM, (bf16_t*)(C.ws + WS_WBA), 768, 0, nullptr, scr, r, C.lane); continue; } r -= I_BA;
        if (r < I_BB) { transpose_item(w_bb, 512, DM, (bf16_t*)(C.ws + WS_WBB), 512, 0, nullptr, scr, r, C.lane); continue; } r -= I_BB;
        if (r < I_BB) { transpose_item(w_bc, 512, DM, (bf16_t*)(C.ws + WS_WBC), 512, 0, nullptr, scr, r, C.lane); continue; } r -= I_BB;
        if (r < I_OUT) { transpose_item(w_out, DM, DM, (bf16_t*)(C.ws + WS_WOUT3), DM, 0, nullptr, scr, r, C.lane); continue; } r -= I_OUT;
        if (r < I_UP) { transpose_item(w_up, DM, DFF, (bf16_t*)(C.ws + WS_WUP), DM, 0, g_mlp, scr, r, C.lane); continue; } r -= I_UP;
        if (r < I_DOWN) { transpose_item(w_down, DFF, DM, (bf16_t*)(C.ws + WS_WDOWN), UP, 0, nullptr, scr, r, C.lane); continue; } r -= I_DOWN;
        if (r < I_PG) { transpose_item(w_pg, DM, DM, (bf16_t*)(C.ws + WS_WPG), DM, 0, g_ple, scr, r, C.lane); continue; } r -= I_PG;
        transpose_item(w_pe, PLE, DM, (bf16_t*)(C.ws + WS_WPE), PLE, 0, nullptr, scr, r, C.lane);
    }
    const int gt = C.gw * 64 + C.lane, ngt = C.ngw * 64;
    const float* p = (const float*)argp(C.lds, 1) + (size_t)L * MTOK * PLE; bf16_t* pbf = (bf16_t*)(C.ws + WS_PBF);
    for (int i = gt; i < MTOK * PLE / 8; i += ngt) {
        const f32x4 a = *(const GAS f32x4*)(p + (size_t)i * 8), b = *(const GAS f32x4*)(p + (size_t)i * 8 + 4);
        u32x4 w; w.x = cvt_pk_bf16(a.x, a.y); w.y = cvt_pk_bf16(a.z, a.w); w.z = cvt_pk_bf16(b.x, b.y); w.w = cvt_pk_bf16(b.z, b.w);
        *(GAS u32x4*)(pbf + (size_t)i * 8) = w;
    }
    const GAS float* sgw = (const GAS float*)argp(C.lds, 8) + (size_t)L * 4 * 128 * 128; bf16_t* sgb = (bf16_t*)(C.ws + WS_SGW);
    for (int i = gt; i < 4 * 128 * 128 / 2; i += ngt) {
        const int e = i * 2, s = e & 127, t = (e >> 7) & 127;
        const float a = (s <= t) ? sgw[e] : 0.f, b = (s + 1 <= t) ? sgw[e + 1] : 0.f;
        *(GAS unsigned*)(sgb + e) = cvt_pk_bf16(a, b);
    }
}

DI void phase_attn(const Ctx& C, bf16_t* Z, float* lse, bool dry) {
    const int tid = C.tid, lane = C.lane, w = C.wave, fr = lane & 15, fq = lane >> 4;
    LAS bf16_t* Ks = (LAS bf16_t*)C.lds;
    LAS bf16_t* Vt = (LAS bf16_t*)(C.lds + 36864);
    const int upc = 3072 / C.gsz, urem = 3072 - upc * C.gsz, nmine = upc + (C.bid < urem ? 1 : 0);
    int cslot = 1;
    for (int ui = 0; ui < nmine; ++ui) {
        const int uid = ui < upc ? C.bid * upc + ui : C.gsz * upc + C.bid;
        const int j = uid & 31, head = (uid >> 5) % 12, bl = uid / 384;
        const int g = head >> 2, dsh = 2 * g, nsh = 5 - dsh;
        const int r = j >> nsh, n = j & ((1 << nsh) - 1);
        const size_t rowb = (size_t)bl * SEQ + r;
        const bool reuse = (ui > 0) && (ui < upc) && (n > 0);
        cslot = reuse ? (cslot ^ 1) : 1;
        const int rot = 128 * (1 - cslot), rot16 = rot >> 4;
#pragma unroll
        for (int cc = 0; cc < 4; ++cc) {
            if (cc < 2 && reuse) continue;
            const int c = tid + cc * 512, kj = c >> 3, ch = c & 7, mm = (n - 1) * 128 + kj, pk = (kj + rot) & 255;
            u32x4 kv = {0u, 0u, 0u, 0u}, vv = {0u, 0u, 0u, 0u};
            if (mm >= 0) { const bf16_t* p = Z + (rowb + ((size_t)mm << dsh)) * ZW + head * 64 + ch * 8; kv = __builtin_nontemporal_load((const GAS u32x4*)(p + CK)); vv = __builtin_nontemporal_load((const GAS u32x4*)(p + CV)); }
            *(LAS u32x4*)(Ks + pk * 72 + ch * 8) = kv;
            LAS bf16_t* vp = Vt + (ch * 8) * 264 + (pk ^ (ch << 3));
            vp[0 * 264] = (bf16_t)(vv.x & 0xffffu); vp[1 * 264] = (bf16_t)(vv.x >> 16);
            vp[2 * 264] = (bf16_t)(vv.y & 0xffffu); vp[3 * 264] = (bf16_t)(vv.y >> 16);
            vp[4 * 264] = (bf16_t)(vv.z & 0xffffu); vp[5 * 264] = (bf16_t)(vv.z >> 16);
            vp[6 * 264] = (bf16_t)(vv.w & 0xffffu); vp[7 * 264] = (bf16_t)(vv.w >> 16);
        }
        const int qi = 16 * w + fr; const size_t qrow = rowb + ((size_t)(n * 128 + qi) << dsh);
        bf16_t* qp = Z + qrow * ZW + head * 64;
        const bf16x8 qf0 = __builtin_nontemporal_load((const GAS bf16x8*)(qp + 8 * fq)), qf1 = __builtin_nontemporal_load((const GAS bf16x8*)(qp + 32 + 8 * fq));
        __syncthreads();
        const int t0 = w < 6 ? w : 6;
        f32x4 st[10];
#pragma unroll
        for (int x = 0; x < 10; ++x) {
            const LAS bf16_t* kp = Ks + (16 * ((t0 + x + rot16) & 15) + fr) * 72 + 8 * fq;
            const bf16x8 a0 = *(const LAS bf16x8*)kp, a1 = *(const LAS bf16x8*)(kp + 32);
            f32x4 acc = {0.f, 0.f, 0.f, 0.f};
            acc = __builtin_amdgcn_mfma_f32_16x16x32_bf16(a0, qf0, acc, 0, 0, 0);
            acc = __builtin_amdgcn_mfma_f32_16x16x32_bf16(a1, qf1, acc, 0, 0, 0);
            st[x] = acc;
        }
        float mx = -INFINITY;
#pragma unroll
        for (int x = 0; x < 10; ++x)
#pragma unroll
            for (int i = 0; i < 4; ++i) {
                const int kj = 16 * (t0 + x) + 4 * fq + i, dist = qi + 128 - kj;
                const bool valid = (dist >= 0) && (dist <= 128) && (n > 0 || kj >= 128);
                const float s = valid ? st[x][i] : -INFINITY; st[x][i] = s; mx = fmaxf(mx, s);
            }
        mx = fmaxf(mx, lane_xor<16>(mx)); mx = max_xor32(mx);
        float sum = 0.f;
#pragma unroll
        for (int x = 0; x < 10; ++x)
#pragma unroll
            for (int i = 0; i < 4; ++i) { const float p = __builtin_amdgcn_exp2f((st[x][i] - mx) * 1.4426950408889634f); st[x][i] = p; sum += p; }
        sum += lane_xor<16>(sum); sum = sum_xor32(sum);
        f32x4 o[4];
#pragma unroll
        for (int dt = 0; dt < 4; ++dt) o[dt] = (f32x4){0.f, 0.f, 0.f, 0.f};
#pragma unroll
        for (int y = 0; y < 5; ++y) {
            u32x4 pw; pw.x = cvt_pk_bf16(st[2 * y][0], st[2 * y][1]); pw.y = cvt_pk_bf16(st[2 * y][2], st[2 * y][3]);
            pw.z = cvt_pk_bf16(st[2 * y + 1][0], st[2 * y + 1][1]); pw.w = cvt_pk_bf16(st[2 * y + 1][2], st[2 * y + 1][3]);
            const bf16x8 pb = __builtin_bit_cast(bf16x8, pw);
            const int ka = 16 * ((t0 + 2 * y + rot16) & 15) + 4 * fq, kb = 16 * ((t0 + 2 * y + 1 + rot16) & 15) + 4 * fq;
#pragma unroll
            for (int dt = 0; dt < 4; ++dt) {
                const LAS bf16_t* vr = Vt + (16 * dt + fr) * 264; const int sw = ((2 * dt + (fr >> 3)) & 7) << 3;
                const s16x4 va = *(const LAS s16x4*)(vr + (ka ^ sw)), vb = *(const LAS s16x4*)(vr + (kb ^ sw));
                const bf16x8 a = {va[0], va[1], va[2], va[3], vb[0], vb[1], vb[2], vb[3]};
                o[dt] = __builtin_amdgcn_mfma_f32_16x16x32_bf16(a, pb, o[dt], 0, 0, 0);
            }
        }
        const float inv = 1.0f / sum;
        bf16_t* qst = dry ? (bf16_t*)(C.ws + WS_PP) + tid * 64 : qp;
#pragma unroll
        for (int dt = 0; dt < 4; ++dt) {
            u32x2 wv; wv.x = cvt_pk_bf16(o[dt][0] * inv, o[dt][1] * inv); wv.y = cvt_pk_bf16(o[dt][2] * inv, o[dt][3] * inv);
            *(GAS u32x2*)(qst + 16 * dt + 4 * fq) = wv;
        }
        if (fq == 0) *(GAS float*)(dry ? (float*)(C.ws + WS_PP) + 1048576 + tid : lse + qrow * 12 + head) = mx + __builtin_amdgcn_logf(sum) * 0.6931471805599453f;
        __syncthreads();
    }
}

DI void phase_mix(const Ctx& C, bf16_t* Z, const float* lse_, int L, bool dry) {
    const GAS float* lse = (const GAS float*)lse_;
    bf16_t* dummy = (bf16_t*)(C.ws + WS_PP) + C.tid * 64;
    const int gt = C.bid * 512 + C.tid, ngt = C.gsz * 512;
    for (int base = gt; base < MTOK * 96; base += 8 * ngt) {
        u32x4 v[8]; float l0[8], l1[8], l2[8];
#pragma unroll
        for (int k = 0; k < 8; ++k) {
            const int idx = base + k * ngt;
            if (idx < MTOK * 96) {
                const int lrow = idx / 96, rem = idx - lrow * 96, head = rem >> 3, ch = rem & 7, slot = head & 3;
                l0[k] = lse[(size_t)lrow * 12 + slot]; l1[k] = lse[(size_t)lrow * 12 + 4 + slot]; l2[k] = lse[(size_t)lrow * 12 + 8 + slot];
                v[k] = __builtin_nontemporal_load((const GAS u32x4*)(Z + (size_t)lrow * ZW + head * 64 + ch * 8));
            }
        }
#pragma unroll
        for (int k = 0; k < 8; ++k) {
            const int idx = base + k * ngt;
            if (idx < MTOK * 96) {
                const int lrow = idx / 96, rem = idx - lrow * 96, head = rem >> 3, ch = rem & 7, g = head >> 2;
                const float mx = fmaxf(l0[k], fmaxf(l1[k], l2[k]));
                const float e0 = __builtin_amdgcn_exp2f((l0[k] - mx) * 1.4426950408889634f), e1 = __builtin_amdgcn_exp2f((l1[k] - mx) * 1.4426950408889634f), e2 = __builtin_amdgcn_exp2f((l2[k] - mx) * 1.4426950408889634f);
                const float al = (g == 0 ? e0 : (g == 1 ? e1 : e2)) / (e0 + e1 + e2);
                bf16_t* p = Z + (size_t)lrow * ZW + head * 64 + ch * 8;
                u32x4 w;
                w.x = cvt_pk_bf16(bf_lo(v[k].x) * al, bf_hi(v[k].x) * al); w.y = cvt_pk_bf16(bf_lo(v[k].y) * al, bf_hi(v[k].y) * al);
                w.z = cvt_pk_bf16(bf_lo(v[k].z) * al, bf_hi(v[k].z) * al); w.w = cvt_pk_bf16(bf_lo(v[k].w) * al, bf_hi(v[k].w) * al);
                *(GAS u32x4*)(dry ? dummy : p) = w;
            }
        }
    }
    const float* cw = (const float*)argp(C.lds, 5) + (size_t)L * 3 * 512;
    for (int base = gt; base < MTOK * 64; base += 4 * ngt) {
        u32x4 xv[4][3], cv[4][3], bv[4];
#pragma unroll
        for (int k = 0; k < 4; ++k) {
            const int idx = base + k * ngt; const int lrow = idx >> 6, c0 = (idx & 63) * 8, t = lrow & (SEQ - 1);
#pragma unroll
            for (int jj = 0; jj < 3; ++jj) {
                const int back = 2 - jj; xv[k][jj] = (u32x4){0u, 0u, 0u, 0u}; cv[k][jj] = (u32x4){0u, 0u, 0u, 0u};
                if (idx < MTOK * 64 && t >= back) { const bf16_t* zr = Z + (size_t)(lrow - back) * ZW + c0; xv[k][jj] = *(const GAS u32x4*)(zr + CX); cv[k][jj] = *(const GAS u32x4*)(zr + CC); }
            }
            bv[k] = (u32x4){0u, 0u, 0u, 0u};
            if (idx < MTOK * 64) bv[k] = __builtin_nontemporal_load((const GAS u32x4*)(Z + (size_t)lrow * ZW + CB + c0));
        }
#pragma unroll
        for (int k = 0; k < 4; ++k) {
            const int idx = base + k * ngt; const int lrow = idx >> 6, c0 = (idx & 63) * 8;
            if (idx < MTOK * 64) {
                float accv[8];
#pragma unroll
                for (int e = 0; e < 8; ++e) accv[e] = 0.f;
#pragma unroll
                for (int jj = 0; jj < 3; ++jj) {
                    const f32x4 w0 = *(const GAS f32x4*)(cw + jj * 512 + c0), w1 = *(const GAS f32x4*)(cw + jj * 512 + c0 + 4);
                    const u32x4 x_ = xv[k][jj], c_ = cv[k][jj];
                    accv[0] += w0.x * bf_lo(x_.x) * bf_lo(c_.x); accv[1] += w0.y * bf_hi(x_.x) * bf_hi(c_.x);
                    accv[2] += w0.z * bf_lo(x_.y) * bf_lo(c_.y); accv[3] += w0.w * bf_hi(x_.y) * bf_hi(c_.y);
                    accv[4] += w1.x * bf_lo(x_.z) * bf_lo(c_.z); accv[5] += w1.y * bf_hi(x_.z) * bf_hi(c_.z);
                    accv[6] += w1.z * bf_lo(x_.w) * bf_lo(c_.w); accv[7] += w1.w * bf_hi(x_.w) * bf_hi(c_.w);
                }
                bf16_t* bp = Z + (size_t)lrow * ZW + CB + c0;
                u32x4 w;
                w.x = cvt_pk_bf16(bf_lo(bv[k].x) * accv[0], bf_hi(bv[k].x) * accv[1]); w.y = cvt_pk_bf16(bf_lo(bv[k].y) * accv[2], bf_hi(bv[k].y) * accv[3]);
                w.z = cvt_pk_bf16(bf_lo(bv[k].z) * accv[4], bf_hi(bv[k].z) * accv[5]); w.w = cvt_pk_bf16(bf_lo(bv[k].w) * accv[6], bf_hi(bv[k].w) * accv[7]);
                *(GAS u32x4*)(dry ? dummy : bp) = w;
            }
        }
    }
    const int lane = C.lane, w = C.wave, fr = lane & 15, fq = lane >> 4, tid = C.tid;
    LAS bf16_t* Vt2 = (LAS bf16_t*)C.lds;
    LAS float* stat = (LAS float*)(C.lds + 34816);
    const bf16_t* sgw = (const bf16_t*)(C.ws + WS_SGW);
    const float* ln_g = (const float*)argp(C.lds, 6) + L * 512; const float* ln_b = (const float*)argp(C.lds, 7) + L * 512; const GAS float* sg_b = (const GAS float*)argp(C.lds, 9) + L * 512;
    for (int ck = C.bid; ck < MTOK / 128; ck += C.gsz) {
        const int row0 = ck * 128;
        {
            const int tk = tid >> 2, q4 = tid & 3;
            const bf16_t* vr = Z + (size_t)(row0 + tk) * ZW + CVV + q4 * 128;
            float s1 = 0.f, s2 = 0.f;
#pragma unroll
            for (int i = 0; i < 16; ++i) {
                const u32x4 raw = *(const GAS u32x4*)(vr + i * 8);
                const float x0 = bf_lo(raw.x), x1 = bf_hi(raw.x), x2 = bf_lo(raw.y), x3 = bf_hi(raw.y), x4 = bf_lo(raw.z), x5 = bf_hi(raw.z), x6 = bf_lo(raw.w), x7 = bf_hi(raw.w);
                s1 += ((x0 + x1) + (x2 + x3)) + ((x4 + x5) + (x6 + x7));
                s2 += ((x0 * x0 + x1 * x1) + (x2 * x2 + x3 * x3)) + ((x4 * x4 + x5 * x5) + (x6 * x6 + x7 * x7));
            }
            s1 += lane_xor<1>(s1); s1 += lane_xor<2>(s1); s2 += lane_xor<1>(s2); s2 += lane_xor<2>(s2);
            const float mean = s1 * (1.0f / 512.0f), var = fmaxf(s2 * (1.0f / 512.0f) - mean * mean, 0.f);
            if (q4 == 0) { stat[tk * 2] = mean; stat[tk * 2 + 1] = 1.0f / sqrtf(var + 1e-5f); }
        }
        __syncthreads();
        u32x4 raw[4];
#pragma unroll
        for (int cc = 0; cc < 4; ++cc) { const int c = tid + cc * 512, tk = c >> 4, ch = c & 15; raw[cc] = *(const GAS u32x4*)(Z + (size_t)(row0 + tk) * ZW + CVV + ch * 8); }
        for (int g = 0; g < 4; ++g) {
        const int tkE = 16 * w + fr;
        bf16_t* up = Z + (size_t)(row0 + tkE) * ZW + CU + g * 128 + 4 * fq;
        u32x2 uq[8];
#pragma unroll
        for (int ct = 0; ct < 8; ++ct) uq[ct] = __builtin_nontemporal_load((const GAS u32x2*)(up + 16 * ct));
        const float bias = sg_b[g * 128 + tkE];
#pragma unroll
        for (int cc = 0; cc < 4; ++cc) {
            const int c = tid + cc * 512, tk = c >> 4, ch = c & 15, c0 = g * 128 + ch * 8;
            const u32x4 rw = raw[cc];
            const float mean = stat[tk * 2], rstd = stat[tk * 2 + 1];
            const f32x4 g0 = *(const GAS f32x4*)(ln_g + c0), g1 = *(const GAS f32x4*)(ln_g + c0 + 4), b0 = *(const GAS f32x4*)(ln_b + c0), b1 = *(const GAS f32x4*)(ln_b + c0 + 4);
            LAS bf16_t* vp = Vt2 + (ch * 8) * 136 + (tk ^ (ch << 3));
            const unsigned p0 = cvt_pk_bf16((bf_lo(rw.x) - mean) * rstd * g0.x + b0.x, (bf_hi(rw.x) - mean) * rstd * g0.y + b0.y);
            const unsigned p1 = cvt_pk_bf16((bf_lo(rw.y) - mean) * rstd * g0.z + b0.z, (bf_hi(rw.y) - mean) * rstd * g0.w + b0.w);
            const unsigned p2 = cvt_pk_bf16((bf_lo(rw.z) - mean) * rstd * g1.x + b1.x, (bf_hi(rw.z) - mean) * rstd * g1.y + b1.y);
            const unsigned p3 = cvt_pk_bf16((bf_lo(rw.w) - mean) * rstd * g1.z + b1.z, (bf_hi(rw.w) - mean) * rstd * g1.w + b1.w);
            vp[0 * 136] = (bf16_t)(p0 & 0xffffu); vp[1 * 136] = (bf16_t)(p0 >> 16); vp[2 * 136] = (bf16_t)(p1 & 0xffffu); vp[3 * 136] = (bf16_t)(p1 >> 16);
            vp[4 * 136] = (bf16_t)(p2 & 0xffffu); vp[5 * 136] = (bf16_t)(p2 >> 16); vp[6 * 136] = (bf16_t)(p3 & 0xffffu); vp[7 * 136] = (bf16_t)(p3 >> 16);
        }
        __syncthreads();
        if (g < 3) {
#pragma unroll
            for (int cc = 0; cc < 4; ++cc) { const int c = tid + cc * 512, tk = c >> 4, ch = c & 15; raw[cc] = *(const GAS u32x4*)(Z + (size_t)(row0 + tk) * ZW + CVV + (g + 1) * 128 + ch * 8); }
        }
        f32x4 acc[8];
#pragma unroll
        for (int ct = 0; ct < 8; ++ct) acc[ct] = (f32x4){0.f, 0.f, 0.f, 0.f};
        const bf16_t* wrow = sgw + (size_t)(g * 128 + 16 * w + fr) * 128 + 8 * fq;
        const int nks = (w >> 1) + 1;
        for (int ks = 0; ks < nks; ++ks) {
            const bf16x8 bw = *(const GAS bf16x8*)(wrow + 32 * ks);
#pragma unroll
            for (int ct = 0; ct < 8; ++ct) {
                const bf16x8 av = *(const LAS bf16x8*)(Vt2 + (16 * ct + fr) * 136 + ((32 * ks + 8 * fq) ^ (((2 * ct + (fr >> 3)) & 15) << 3)));
                acc[ct] = __builtin_amdgcn_mfma_f32_16x16x32_bf16(av, bw, acc[ct], 0, 0, 0);
            }
        }
#pragma unroll
        for (int ct = 0; ct < 8; ++ct) {
            const u32x2 uv = uq[ct]; u32x2 wv;
            wv.x = cvt_pk_bf16(bf_lo(uv.x) * (acc[ct][0] + bias), bf_hi(uv.x) * (acc[ct][1] + bias));
            wv.y = cvt_pk_bf16(bf_lo(uv.y) * (acc[ct][2] + bias), bf_hi(uv.y) * (acc[ct][3] + bias));
            *(GAS u32x2*)(dry ? dummy + 16 * ct : up + 16 * ct) = wv;
        }
        __syncthreads();
        }
    }
}

DI void phase_final(const Ctx& C) {
    GAS float* out = (GAS float*)argp(C.lds, 21); const GAS bf16_t* hb = (const GAS bf16_t*)(C.ws + WS_HBB); const GAS float* ssqC = (const GAS float*)(C.ws + WS_SSQC); const GAS float* gf = (const GAS float*)argp(C.lds, 20);
    f32x4 g[4];
#pragma unroll
    for (int j = 0; j < 4; ++j) g[j] = ((const GAS f32x4*)gf + C.lane)[64 * j];
    for (int m0 = C.gw; m0 < MTOK; m0 += 4 * C.ngw) {
        u32x2 hv[4][4]; float sq[4];
#pragma unroll
        for (int k = 0; k < 4; ++k) { const int m = m0 + k * C.ngw; sq[k] = 0.f; if (m < MTOK) {
            sq[k] = (C.lane < 16) ? ssqC[(size_t)m * 16 + C.lane] : 0.f;
            const GAS u32x2* hr = (const GAS u32x2*)(hb + (size_t)m * DM) + C.lane;
#pragma unroll
            for (int j = 0; j < 4; ++j) hv[k][j] = __builtin_nontemporal_load(hr + 64 * j); } }
#pragma unroll
        for (int k = 0; k < 4; ++k) { const int m = m0 + k * C.ngw; if (m < MTOK) {
            const float rs = 1.0f / sqrtf(wave_sum(sq[k]) * (1.0f / 1024.0f) + 1e-6f);
            GAS f32x4* orow = (GAS f32x4*)(out + (size_t)m * DM) + C.lane;
#pragma unroll
            for (int j = 0; j < 4; ++j) { const u32x2 h2 = hv[k][j];
                f32x4 v; v.x = bf_lo(h2.x) * rs * g[j].x; v.y = bf_hi(h2.x) * rs * g[j].y; v.z = bf_lo(h2.y) * rs * g[j].z; v.w = bf_hi(h2.y) * rs * g[j].w; orow[64 * j] = v; } } }
    }
}

#define XB_TMO      128
#define XB_XCNT(j)  (256  + 64 * (j))
#define XB_XSUB(j)  (1280 + 64 * (j))
#define XB_XGEN(j)  (2304 + 64 * (j))
#define XB_TOP      3328
#define XB_TOPGEN   3392
#define XCD_BAR_WORDS 3456
#define XB_SPIN_CAP (1u << 18)

__device__ __forceinline__ unsigned xb_ld(unsigned* p)              { return __hip_atomic_load(p, __ATOMIC_RELAXED, __HIP_MEMORY_SCOPE_AGENT); }
__device__ __forceinline__ unsigned xb_add(unsigned* p, unsigned v) { return __hip_atomic_fetch_add(p, v, __ATOMIC_RELAXED, __HIP_MEMORY_SCOPE_AGENT); }
__device__ __forceinline__ unsigned xb_xcc_id() { return (unsigned)__builtin_amdgcn_s_getreg((3 << 11) | 20) & 0xFu; }
#define XB_SPIN(cond, bar) do { unsigned _sp = 0; while (cond) { __builtin_amdgcn_s_sleep(1); \
    if ((++_sp & 255u) == 0u) { if (xb_ld(&(bar)[XB_TMO])) break; if (_sp > XB_SPIN_CAP) { atomicAdd(&(bar)[XB_TMO], 1u); break; } } } } while (0)

struct XcdBarrier {
    unsigned* bar; unsigned x;
    volatile LAS unsigned* st;
};

__device__ __forceinline__ XcdBarrier xcd_barrier_post(unsigned* bar, volatile LAS unsigned* st) {
    XcdBarrier b; b.bar = bar; b.x = xb_xcc_id(); b.st = st;
    if (threadIdx.x == 0) (void)xb_add(&bar[XB_XCNT(b.x)], 1u);
    return b;
}
__device__ __forceinline__ void xcd_barrier_complete(unsigned* bar, unsigned x, unsigned& nloc, unsigned& nx) {
    const unsigned G = gridDim.x * gridDim.y * gridDim.z;
    unsigned sum, cnt, mine, sp = 0u;
    for (;;) {
        sum = 0u; cnt = 0u; mine = 0u;
#pragma unroll
        for (unsigned j = 0; j < 16; ++j) { const unsigned c = xb_ld(&bar[XB_XCNT(j)]); sum += c; cnt += (c > 0u) ? 1u : 0u; mine = (j == x) ? c : mine; }
        if (sum == G) break;
        __builtin_amdgcn_s_sleep(1);
        if ((++sp & 255u) == 0u) { if (xb_ld(&bar[XB_TMO])) break; if (sp > XB_SPIN_CAP) { atomicAdd(&bar[XB_TMO], 1u); break; } }
    }
    nloc = mine > 0u ? mine : 1u; nx = cnt > 0u ? cnt : 1u;
}

__device__ __forceinline__ void xcd_barrier(const XcdBarrier& b) {
    asm volatile("s_waitcnt vmcnt(0)" ::: "memory");
    __syncthreads();
    if (threadIdx.x == 0) {
        unsigned* bar = b.bar;
        __builtin_amdgcn_s_waitcnt(0);
        unsigned nloc = b.st[0], nx = b.st[1];
        if (nloc == 0u) { xcd_barrier_complete(bar, b.x, nloc, nx); b.st[0] = nloc; b.st[1] = nx; }
        const unsigned old = xb_add(&bar[XB_XSUB(b.x)], 1u);
        const unsigned gen = old / nloc;
        if (old + 1u == (gen + 1u) * nloc) {
            __builtin_amdgcn_fence(__ATOMIC_RELEASE, "agent");
            asm volatile("s_waitcnt vmcnt(0)" ::: "memory");
            const unsigned og = xb_add(&bar[XB_TOP], 1u);
            const unsigned tg = og / nx;
            if (og + 1u == (tg + 1u) * nx) xb_add(&bar[XB_TOPGEN], 1u);
            else XB_SPIN(xb_ld(&bar[XB_TOPGEN]) == tg, bar);
            __builtin_amdgcn_fence(__ATOMIC_ACQUIRE, "agent");
            xb_add(&bar[XB_XGEN(b.x)], 1u);
            asm volatile("s_waitcnt vmcnt(0)" ::: "memory");
        } else {
            XB_SPIN(xb_ld(&bar[XB_XGEN(b.x)]) == gen, bar);
            __builtin_amdgcn_fence(__ATOMIC_ACQUIRE, "agent");
            asm volatile("s_waitcnt vmcnt(0)" ::: "memory");
        }
    }
    __syncthreads();
}

__global__ void __launch_bounds__(512) fwd_megakernel(Args args) {
    extern __shared__ __attribute__((aligned(16))) unsigned char lds_raw[];
    cg::grid_group grid = cg::this_grid();
    const int wave_s = __builtin_amdgcn_readfirstlane((int)threadIdx.x >> 6);
    {
        LAS unsigned long long* tb = (LAS unsigned long long*)((LAS unsigned char*)lds_raw + ARG_OFF);
        if (threadIdx.x < 21) tb[threadIdx.x] = (unsigned long long)args.in[threadIdx.x];
        if (threadIdx.x == 21) tb[21] = (unsigned long long)args.out;
        if (threadIdx.x == 22) tb[22] = (unsigned long long)args.ws;
        if (threadIdx.x >= 32 && threadIdx.x < 40) ((LAS float*)(tb + 23))[threadIdx.x - 32] = args.invf[threadIdx.x - 32];
        if (threadIdx.x == 64) { ((LAS unsigned*)((LAS unsigned char*)lds_raw + ARG_OFF + 256))[0] = 0u; ((LAS unsigned*)((LAS unsigned char*)lds_raw + ARG_OFF + 256))[1] = 0u; }
        __syncthreads();
    }
    (void)xcd_barrier_post((unsigned*)(args.ws + WS_BAR), (volatile LAS unsigned*)((LAS unsigned char*)lds_raw + ARG_OFF + 256));
    int rep = 0;
    for (int ph = args.ph_lo; ph < args.ph_hi;) {
        int want = 1;
        const int tid_ = wave_s * 64 + lane_id_opaque();
        int bid_ = blockIdx.x, gsz_ = gridDim.x; asm volatile("" : "+s"(bid_), "+s"(gsz_));
        Ctx C; C.lds = (LAS unsigned char*)lds_raw; C.ws = nullptr; C.tid = tid_; C.lane = C.tid & 63; C.wave = wave_s;
        C.bid = bid_; C.gsz = gsz_;
        unsigned char* ws = (unsigned char*)argp(C.lds, 22); C.ws = ws;
        C.gw = C.bid * 8 + C.wave; C.ngw = C.gsz * 8;
        bf16_t* Z = (bf16_t*)(ws + WS_BIG); bf16_t* U = (bf16_t*)(ws + WS_BIG); bf16_t* PP = (bf16_t*)(ws + WS_PP);
        bf16_t* hbA = (bf16_t*)(ws + WS_HBA); bf16_t* hbB = (bf16_t*)(ws + WS_HBB);
        float* ssqA = (float*)(ws + WS_SSQA); float* ssqB = (float*)(ws + WS_SSQB); float* ssqC = (float*)(ws + WS_SSQC);
        float* lse = (float*)(ws + WS_LSE); float* rope = (float*)(ws + WS_ROPE);
        int njobs = 0, jtype = 0, L = 0;
        if (ph == 0) phase_prologue(C);
        else if (ph == NPHASE - 1) phase_final(C);
        else {
            L = (ph - 1) / 9; const int s = (ph - 1) % 9;
            if (s == 0) { phase_convert(C, L); want = 1 + PROBE_CVT; }
            else if (s == 1) { njobs = 1; jtype = 0; }
            else if (s == 2) { phase_attn(C, Z, lse, false); want = 1 + PROBE_ATTN; }
            else if (s == 3) { phase_mix(C, Z, lse, L, false); want = 1 + PROBE_MIX; }
            else if (s == 4) { njobs = 6; jtype = 1; }
            else if (s == 5) { njobs = 1; jtype = 2; }
            else if (s == 6) { njobs = 1; jtype = 3; }
            else if (s == 7) { njobs = 2; jtype = 4; }
            else { njobs = 1; jtype = 6; }
        }
        for (int ji = 0; ji < njobs; ++ji) {
            const int jt = jtype == 1 ? ((ji & 1) ? 1 : 0) : (jtype + ((jtype == 4) ? ji : 0));
            const bool gate_job = (jtype == 1);
            if (jt == 0) {
                const int b = ji >> 1;
                EpiIn E{gate_job ? (bf16_t*)(ws + WS_G) : Z, ssqC, rope, (bf16_t*)nullptr, gate_job ? DM : ZW, gate_job ? 4 : -1};
                want = gate_job ? 1 + PROBE_GATE : 1 + PROBE_IN + PROBE_INDRY;
                run_gemm(C.lds, C.bid, C.gsz, C.wave, hbB, DM, (const bf16_t*)(ws + WS_WIN) + (gate_job ? (size_t)(ZW + b * DM) * DM : 0), MTOK, gate_job ? DM : ZW, DM, E);
            } else if (jt == 1) {
                const int b = ji >> 1;
                const int ca = b == 0 ? CQ : (b == 1 ? CB : CU); const int kk = b == 0 ? 768 : 512;
                const bf16_t* bt = (const bf16_t*)(ws + (b == 0 ? WS_WBA : (b == 1 ? WS_WBB : WS_WBC)));
                EpiGate E{(const bf16_t*)(ws + WS_G), Z + CK, b > 0, (bf16_t*)nullptr}; want = 1 + PROBE_GATE; run_gemm(C.lds, C.bid, C.gsz, C.wave, Z + ca, ZW, bt, MTOK, DM, kk, E);
            } else if (jt == 2 || jt == 4) {
                const bool mix = (jt == 2);
                EpiRes E{mix ? hbB : hbA, hbA, mix ? ssqA : ssqB, (float*)nullptr};
                want = 1 + (mix ? PROBE_RESMIX : PROBE_DOWN);
                run_gemm(C.lds, C.bid, C.gsz, C.wave, mix ? Z + CK : U, mix ? ZW : UP, (const bf16_t*)(ws + (mix ? WS_WOUT3 : WS_WDOWN)), MTOK, DM, mix ? DM : DFF, E, mix ? DM : UP);
            } else if (jt == 3) { EpiUp E{U, ssqA}; want = 1 + PROBE_UP; run_gemm(C.lds, C.bid, C.gsz, C.wave, hbA, DM, (const bf16_t*)(ws + WS_WUP), MTOK, DFF, DM, E); }
            else if (jt == 5) { EpiPlain E{PP, DM}; run_gemm(C.lds, C.bid, C.gsz, C.wave, (const bf16_t*)(ws + WS_PBF), PLE, (const bf16_t*)(ws + WS_WPE), MTOK, DM, PLE, E); }
            else { EpiPle E{hbA, PP, ssqB, hbB, ssqC, (float*)nullptr}; want = 1 + PROBE_PLE; run_gemm(C.lds, C.bid, C.gsz, C.wave, hbA, DM, (const bf16_t*)(ws + WS_WPG), MTOK, DM, DM, E); }
        }
        if (++rep >= want) { rep = 0; ++ph; }
        if (ph < args.ph_hi) {
            if (ph == 1 && rep == 0) grid.sync();
            else {
                XcdBarrier xbar; xbar.bar = (unsigned*)(ws + WS_BAR); xbar.x = xb_xcc_id(); xbar.st = (volatile LAS unsigned*)(C.lds + ARG_OFF + 256);
                xcd_barrier(xbar); if (PROBE_SYNC) xcd_barrier(xbar);
            }
        }
    }
}

extern "C" void kernel_launch(void* const* d_in, const int* in_sizes, int n_in, void* d_out, int out_size, void* d_ws, size_t ws_size, hipStream_t stream) {
    static int grid = 0;
    if (grid == 0) {
        if (n_in != 21 || out_size != MTOK * DM || ws_size < WS_END) { fprintf(stderr, "kernel_launch: unexpected sizes (n_in %d out %d ws %zu)\n", n_in, out_size, ws_size); grid = -1; return; }
        int dev = 0, cus = 0, per_cu = 0;
        (void)hipGetDevice(&dev); (void)hipDeviceGetAttribute(&cus, hipDeviceAttributeMultiprocessorCount, dev);
        (void)hipFuncSetAttribute((const void*)fwd_megakernel, hipFuncAttributeMaxDynamicSharedMemorySize, LDS_BYTES);
        (void)hipOccupancyMaxActiveBlocksPerMultiprocessor(&per_cu, (const void*)fwd_megakernel, 512, LDS_BYTES);
        (void)hipGetLastError();
        if (per_cu < 1) per_cu = 1;
        grid = cus;
        if (grid <= 0) grid = 256;
    }
    if (grid < 0) return;
    (void)hipMemsetAsync((char*)d_ws + WS_BAR, 0, 16384, stream);
    Args a{};
    for (int i = 0; i < 21; ++i) a.in[i] = d_in[i];
    a.out = (float*)d_out; a.ws = (unsigned char*)d_ws;
    for (int j = 0; j < 8; ++j) a.invf[j] = (float)pow(500000.0, -(double)(2 * j) / 16.0);
#if MK_PER_PHASE_LAUNCH
    for (int ph = 0; ph < NPHASE; ++ph) { a.ph_lo = ph; a.ph_hi = ph + 1; hipLaunchKernelGGL(fwd_megakernel, dim3(grid), dim3(512), LDS_BYTES, stream, a); }
#else
    a.ph_lo = 0; a.ph_hi = NPHASE;
    void* kargs[] = {&a};
    hipError_t e = hipLaunchCooperativeKernel((const void*)fwd_megakernel, dim3(grid), dim3(512), kargs, LDS_BYTES, stream);
    if (e != hipSuccess) fprintf(stderr, "cooperative launch failed: %s (grid %d)\n", hipGetErrorString(e), grid);
#endif
}
```

```cpp
#include <hip/hip_runtime.h>
#include <hip/hip_cooperative_groups.h>
#include <cstdio>
#include <cstdint>
#include <cmath>
namespace cg = cooperative_groups;
#ifndef PROBE_ATTN
#define PROBE_ATTN 0
#endif
#ifndef PROBE_MIX
#define PROBE_MIX 0
#endif
#ifndef PROBE_CVT
#define PROBE_CVT 0
#endif
#ifndef PROBE_IN
#define PROBE_IN 0
#endif
#ifndef PROBE_UP
#define PROBE_UP 0
#endif
#ifndef PROBE_GATE
#define PROBE_GATE 0
#endif
#ifndef PROBE_RESMIX
#define PROBE_RESMIX 0
#endif
#ifndef PROBE_DOWN
#define PROBE_DOWN 0
#endif
#ifndef PROBE_PLE
#define PROBE_PLE 0
#endif
#ifndef PROBE_INDRY
#define PROBE_INDRY 0
#endif
#ifndef PROBE_SYNC
#define PROBE_SYNC 0
#endif
#ifndef MK_PER_PHASE_LAUNCH
#define MK_PER_PHASE_LAUNCH 0
#endif
__device__ __forceinline__ int lane_id_opaque();
namespace pg8 {
#define PG8_LAS __attribute__((address_space(3)))
typedef unsigned short bf16_t;
typedef short bf16x8 __attribute__((ext_vector_type(8)));
typedef float f32x4 __attribute__((ext_vector_type(4)));
typedef unsigned u32x4 __attribute__((ext_vector_type(4)));
constexpr int BM = 256, BK = 64, HALF = 128, HTB = HALF * BK * 2  , STAGE_BYTES = 8 * HTB, NXCD = 8, WGM = 4;

__host__ __device__ __forceinline__ int lds_byte(int r, int c) { const int st = (r >> 4) * 2 + (c >> 5), rr = r & 15, cc = c & 31, ob = rr * 64 + cc * 2; return st * 1024 + (ob ^ (((ob >> 9) & 1) << 5)); }
__host__ __device__ __forceinline__ void stage_rc(int b, int& R, int& C) { const int st = b / 1024, sb = b % 1024, swz = sb ^ (((sb >> 9) & 1) << 5); R = (st >> 1) * 16 + swz / 64; C = (st & 1) * 32 + (swz % 64) / 2; }
__host__ __device__ __forceinline__ int perm32(int rho) { const int n = rho >> 4, i = rho & 15; return 8 * (i >> 2) + 4 * n + (i & 3); }

struct Unit { int pm, pn; };
struct Gemm { const bf16_t* A; int lda; const bf16_t* Bt; int ldb; int M, N, K, wave; };

struct StaticOrder {
    int nM, nN, nwg, G, c;
    __host__ __device__ void init(int M, int N, int G_, int c_) { nM = M / BM; nN = N / BM; nwg = nM * nN; G = G_; c = c_; }
    __host__ __device__ bool next(int i, Unit& u) const {
        const long L = (long)i * G + c; if (L >= nwg) return false;
        int wgid = (int)L; { const int q = nwg / NXCD, r = nwg % NXCD, xcd = wgid % NXCD, off = wgid / NXCD; wgid = (xcd < r ? xcd * (q + 1) : r * (q + 1) + (xcd - r) * q) + off; }
        const int nig = WGM * nN, gid = wgid / nig, fm = gid * WGM, gsz = (nM - fm) < WGM ? (nM - fm) : WGM;
        u.pm = fm + ((wgid % nig) % gsz); u.pn = (wgid % nig) / gsz; return true;
    }
    __device__ __forceinline__ void a_ready(const Unit&) const {}
    __device__ __forceinline__ void done(const Unit&) const {}
};

__device__ __forceinline__ unsigned cvt_pk_bf16(float lo, float hi) { unsigned r; asm volatile("v_cvt_pk_bf16_f32 %0, %1, %2" : "=v"(r) : "v"(lo), "v"(hi)); return r; }
typedef float f32x2 __attribute__((ext_vector_type(2)));
__device__ __forceinline__ f32x2 gelu_pk(f32x2 v) {
    const f32x2 av = __builtin_elementwise_abs(v), d = av * 0.2316418882f + 1.0f;
    f32x2 t; t.x = __builtin_amdgcn_rcpf(d.x); t.y = __builtin_amdgcn_rcpf(d.y);
    f32x2 q = t * 0.5307027145f + (-0.7265760135f); q = q * t + 0.7107068705f; q = q * t + (-0.142248368f); q = q * t + 0.127414796f; q = q * t;
    const f32x2 s = (v * v) * (-0.72134752044f);
    f32x2 e; e.x = __builtin_amdgcn_exp2f(s.x); e.y = __builtin_amdgcn_exp2f(s.y);
    const f32x2 m = v * (q * e), r = v - m;
    f32x2 o; o.x = v.x < 0.f ? m.x : r.x; o.y = v.y < 0.f ? m.y : r.y; return o;
}
template <class Epi, class Sched, bool ALIGN_EPI = false, bool SP2 = false>
__device__ __forceinline__ void gemm_phase(PG8_LAS unsigned char* lds, const Gemm g, const Sched& S, const Epi& E) {
    const int tid = g.wave * 64 + lane_id_opaque(),
        wid = __builtin_amdgcn_readfirstlane(tid >> 6), lane = tid & 63, wr = wid >> 2, wc = wid & 3, fr = lane & 15, fq = lane >> 4;
    const int K = g.K, nt = K / BK;
    unsigned voffA[2], voffB[2];
#pragma unroll
    for (int i = 0; i < 2; ++i) { int R, C; stage_rc(tid * 16 + i * 8192, R, C); const int Rb = Epi::PERM ? ((R & ~31) + perm32(R & 31)) : R;
        voffA[i] = (unsigned)(R * g.lda + C) * 2u; voffB[i] = (unsigned)(Rb * g.ldb + C) * 2u; }
    const size_t kstep = (size_t)(BK * 2);
    const size_t hstepA = (size_t)HALF * g.lda * 2, hstepB = (size_t)HALF * g.ldb * 2;
    const size_t tstepA = 2 * hstepA, tstepB = 2 * hstepB;
    const unsigned ldsw = (unsigned)wid * 1024u;
    const int aoff = lds_byte(wr * 64 + fr, fq * 8), boff = lds_byte(wc * 32 + fr, fq * 8);
#define PG8_SA(b, h) (((b) * 2 + (h)) * HTB)
#define PG8_SB(b, h) ((4 + (b) * 2 + (h)) * HTB)
#define PG8_STAGE(bufoff, gbase, voff) do { _Pragma("unroll") for (int _i = 0; _i < 2; ++_i) \
        __builtin_amdgcn_global_load_lds((const unsigned*)((const char*)(gbase) + (voff)[_i]), (PG8_LAS unsigned*)(lds + (bufoff) + ldsw + _i * 8192), 16, 0, 0); } while (0)
#define PG8_LDA(dst, b, h) do { _Pragma("unroll") for (int m = 0; m < 4; ++m) _Pragma("unroll") for (int k = 0; k < 2; ++k) dst[m][k] = *(const PG8_LAS bf16x8*)(lds + PG8_SA(b, h) + aoff + m * 2048 + k * 1024); } while (0)
#define PG8_LDB(dst, b, h) do { _Pragma("unroll") for (int n = 0; n < 2; ++n) _Pragma("unroll") for (int k = 0; k < 2; ++k) dst[n][k] = *(const PG8_LAS bf16x8*)(lds + PG8_SB(b, h) + boff + n * 2048 + k * 1024); } while (0)
#define PG8_MMA(ai, bj, At, Bt) do { __builtin_amdgcn_s_setprio(1); _Pragma("unroll") for (int m = 0; m < 4; ++m) _Pragma("unroll") for (int n = 0; n < 2; ++n) _Pragma("unroll") for (int k = 0; k < 2; ++k) \
        acc[ai][bj][m][n] = __builtin_amdgcn_mfma_f32_16x16x32_bf16(Bt[n][k], At[m][k], acc[ai][bj][m][n], 0, 0, 0); __builtin_amdgcn_s_setprio(0); } while (0)
#define PG8_WAIT_V(n) asm volatile("s_waitcnt vmcnt(" #n ")" ::: "memory")
#define PG8_WAIT_L(n) asm volatile("s_waitcnt lgkmcnt(" #n ")" ::: "memory")
#define PG8_BAR __builtin_amdgcn_s_barrier()
#define PG8_SCHED __builtin_amdgcn_sched_barrier(0)
    Unit cur, nxt; int ui = 0;
    if (!S.next(0, cur)) return;
    f32x4 acc[2][2][4][2];
#pragma unroll
    for (int a = 0; a < 2; ++a)
#pragma unroll
        for (int b = 0; b < 2; ++b)
#pragma unroll
            for (int m = 0; m < 4; ++m)
#pragma unroll
                for (int n = 0; n < 2; ++n) acc[a][b][m][n] = (f32x4){0.f, 0.f, 0.f, 0.f};
    bf16x8 At[4][2], B0[2][2], B1[2][2];
    const char* cA = (const char*)g.A + (size_t)cur.pm * tstepA; const char* cB = (const char*)g.Bt + (size_t)cur.pn * tstepB;
    S.a_ready(cur);
    if constexpr (SP2) {
        PG8_STAGE(PG8_SB(0, 0), cB, voffB); PG8_STAGE(PG8_SB(0, 1), cB + hstepB, voffB); PG8_STAGE(PG8_SA(0, 0), cA, voffA); PG8_STAGE(PG8_SA(0, 1), cA + hstepA, voffA);
        if (wr == 1) PG8_BAR;
        PG8_WAIT_V(2); PG8_BAR;
        PG8_STAGE(PG8_SB(1, 0), cB + kstep, voffB); PG8_STAGE(PG8_SA(1, 0), cA + kstep, voffA); PG8_STAGE(PG8_SB(1, 1), cB + hstepB + kstep, voffB);
        PG8_WAIT_V(6); PG8_BAR;
    } else {
        PG8_STAGE(PG8_SB(0, 0), cB, voffB); PG8_STAGE(PG8_SA(0, 0), cA, voffA); PG8_STAGE(PG8_SB(0, 1), cB + hstepB, voffB); PG8_STAGE(PG8_SA(0, 1), cA + hstepA, voffA);
        if (wr == 1) PG8_BAR;
        PG8_WAIT_V(4); PG8_BAR;
        PG8_STAGE(PG8_SB(1, 0), cB + kstep, voffB); PG8_STAGE(PG8_SA(1, 0), cA + kstep, voffA); PG8_STAGE(PG8_SB(1, 1), cB + hstepB + kstep, voffB);
        PG8_WAIT_V(6); PG8_BAR;
    }
    for (;;) {
        const bool has_next = S.next(ui + 1, nxt);
        const char* nA = has_next ? (const char*)g.A + (size_t)nxt.pm * tstepA : cA; const char* nB = has_next ? (const char*)g.Bt + (size_t)nxt.pn * tstepB : cB;
        for (int t = 0; t < nt; t += 2) {
            const bool last = (t == nt - 2);
            const char* a1 = cA + (size_t)(t + 1) * kstep;
            const char* a2 = last ? nA : cA + (size_t)(t + 2) * kstep; const char* b2 = last ? nB : cB + (size_t)(t + 2) * kstep;
            const char* a3 = a2 + kstep; const char* b3 = b2 + kstep;
            if (last && has_next) S.a_ready(nxt);
            if constexpr (SP2) {
            PG8_LDB(B0, 0, 0); PG8_LDB(B1, 0, 1); PG8_SCHED; PG8_LDA(At, 0, 0); PG8_STAGE(PG8_SA(1, 1), a1 + hstepA, voffA);
            PG8_WAIT_V(8); PG8_WAIT_L(0); PG8_BAR; PG8_MMA(0, 0, At, B0); PG8_MMA(0, 1, At, B1); PG8_BAR; PG8_SCHED;
            PG8_LDA(At, 0, 1); PG8_STAGE(PG8_SB(0, 0), b2, voffB); PG8_STAGE(PG8_SB(0, 1), b2 + hstepB, voffB); PG8_STAGE(PG8_SA(0, 0), a2, voffA);
            PG8_WAIT_V(8); PG8_WAIT_L(0); PG8_BAR; PG8_MMA(1, 0, At, B0); PG8_MMA(1, 1, At, B1); PG8_BAR; PG8_SCHED;
            PG8_LDB(B0, 1, 0); PG8_LDB(B1, 1, 1); PG8_SCHED; PG8_LDA(At, 1, 0); PG8_STAGE(PG8_SA(0, 1), a2 + hstepA, voffA);
            PG8_WAIT_V(8); PG8_WAIT_L(0); PG8_BAR; PG8_MMA(0, 0, At, B0); PG8_MMA(0, 1, At, B1); PG8_BAR; PG8_SCHED;
            PG8_LDA(At, 1, 1); PG8_STAGE(PG8_SB(1, 0), b3, voffB); PG8_STAGE(PG8_SB(1, 1), b3 + hstepB, voffB); PG8_STAGE(PG8_SA(1, 0), a3, voffA);
            PG8_WAIT_V(8); PG8_WAIT_L(0); PG8_BAR; PG8_MMA(1, 0, At, B0); PG8_MMA(1, 1, At, B1); PG8_BAR; PG8_SCHED;
            } else {
            PG8_LDB(B0, 0, 0); PG8_SCHED; PG8_LDA(At, 0, 0); PG8_STAGE(PG8_SA(1, 1), a1 + hstepA, voffA);
            PG8_WAIT_L(8); PG8_BAR; PG8_WAIT_L(0); PG8_MMA(0, 0, At, B0); PG8_BAR; PG8_SCHED;
            PG8_LDB(B1, 0, 1); PG8_STAGE(PG8_SB(0, 0), b2, voffB);
            PG8_BAR; PG8_WAIT_L(0); PG8_MMA(0, 1, At, B1); PG8_BAR;
            PG8_LDA(At, 0, 1); PG8_STAGE(PG8_SA(0, 0), a2, voffA);
            PG8_BAR; PG8_WAIT_L(0); PG8_MMA(1, 0, At, B0); PG8_BAR; PG8_SCHED;
            PG8_STAGE(PG8_SB(0, 1), b2 + hstepB, voffB);
            PG8_WAIT_V(6); PG8_BAR; PG8_MMA(1, 1, At, B1); PG8_BAR;
            PG8_LDB(B0, 1, 0); PG8_SCHED; PG8_LDA(At, 1, 0); PG8_STAGE(PG8_SA(0, 1), a2 + hstepA, voffA);
            PG8_WAIT_L(8); PG8_BAR; PG8_WAIT_L(0); PG8_MMA(0, 0, At, B0); PG8_BAR; PG8_SCHED;
            PG8_LDB(B1, 1, 1); PG8_STAGE(PG8_SB(1, 0), b3, voffB);
            PG8_BAR; PG8_WAIT_L(0); PG8_MMA(0, 1, At, B1); PG8_BAR;
            PG8_LDA(At, 1, 1); PG8_STAGE(PG8_SA(1, 0), a3, voffA);
            PG8_BAR; PG8_WAIT_L(0); PG8_MMA(1, 0, At, B0); PG8_BAR; PG8_SCHED;
            PG8_STAGE(PG8_SB(1, 1), b3 + hstepB, voffB);
            PG8_WAIT_V(6); PG8_BAR; PG8_MMA(1, 1, At, B1); PG8_BAR;
            }
        }
        if constexpr (ALIGN_EPI) { if (wr == 0) PG8_BAR; }
        if constexpr (!Epi::AFTER_DRAIN) { E(acc, cur, wr, wc, fr, fq); S.done(cur); }
        if (!has_next) break;
#pragma unroll
        for (int a = 0; a < 2; ++a)
#pragma unroll
            for (int b = 0; b < 2; ++b)
#pragma unroll
                for (int m = 0; m < 4; ++m)
#pragma unroll
                    for (int n = 0; n < 2; ++n) acc[a][b][m][n] = (f32x4){0.f, 0.f, 0.f, 0.f};
        cur = nxt; cA = nA; cB = nB; ++ui;
        if constexpr (ALIGN_EPI) { if (wr == 1) PG8_BAR; }
    }
    PG8_WAIT_V(0);
    if constexpr (!ALIGN_EPI) { if (wr == 0) PG8_BAR; }
    PG8_BAR;
    if constexpr (Epi::AFTER_DRAIN) { E.fused(acc, cur, wr, wc, fr, fq, lds, wid, lane); S.done(cur); }
#undef PG8_SA
#undef PG8_SB
#undef PG8_STAGE
#undef PG8_LDA
#undef PG8_LDB
#undef PG8_MMA
#undef PG8_WAIT_V
#undef PG8_WAIT_L
#undef PG8_BAR
#undef PG8_SCHED
}
}

#define DI __device__ __forceinline__
#define LAS __attribute__((address_space(3)))
#define GAS __attribute__((address_space(1)))
typedef unsigned short bf16_t;
typedef float f32x4 __attribute__((ext_vector_type(4)));
typedef float f32x2 __attribute__((ext_vector_type(2)));
typedef unsigned u32x4 __attribute__((ext_vector_type(4)));
typedef unsigned u32x2 __attribute__((ext_vector_type(2)));
typedef short bf16x8 __attribute__((ext_vector_type(8)));
typedef short s16x4 __attribute__((ext_vector_type(4)));

constexpr int DM = 1024, SEQ = 4096, NLAYER = 4, MTOK = 32768, MH = 16384, INW = 7936, DFF = 4096, PLE = 256;
constexpr int UP = 4160;
constexpr int ZW = 4864;
constexpr int CQ = 0, CK = 768, CV = 1536, CX = 2304, CB = 2816, CC = 3328, CU = 3840, CVV = 4352, CG = 4864;
constexpr size_t MiB = 1u << 20;
constexpr size_t WS_ROPE = 0, WS_SSQA = 2 * MiB, WS_SSQB = 4 * MiB, WS_SSQC = 6 * MiB, WS_LSE = 8 * MiB, WS_DUMMY = 9 * MiB + 524288, WS_BAR = 9 * MiB + 655360, WS_SGW = 9 * MiB + 786432,
                 WS_WIN = 10 * MiB, WS_WBA = 26 * MiB, WS_WBB = 28 * MiB, WS_WBC = 29 * MiB, WS_WOUT3 = 30 * MiB, WS_WUP = 36 * MiB,
                 WS_WDOWN = 44 * MiB, WS_WPG = 53 * MiB, WS_WPE = 55 * MiB, WS_PBF = 56 * MiB, WS_HBA = 72 * MiB, WS_HBB = 136 * MiB,
                 WS_BIG = 200 * MiB, WS_PP = 460 * MiB, WS_G = 504 * MiB, WS_END = 568 * MiB;
constexpr int LDS_BYTES = 147456;
constexpr int NPHASE = 2 + NLAYER * 9;

struct Args { const void* in[21]; float* out; unsigned char* ws; float invf[8]; int ph_lo, ph_hi; };

using pg8::cvt_pk_bf16;
DI float bf_lo(unsigned w) { return __uint_as_float(w << 16); }
DI float bf_hi(unsigned w) { return __uint_as_float(w & 0xffff0000u); }
DI int lane_id_opaque() { int l; asm volatile("v_mbcnt_lo_u32_b32 %0, -1, 0\n\tv_mbcnt_hi_u32_b32 %0, -1, %0" : "=v"(l)); return l; }
template <int X> DI float lane_xor(float v) {
    return __int_as_float(__builtin_amdgcn_ds_swizzle(__float_as_int(v), (X << 10) | 0x1f));
}
DI float sum_xor32(float v) { auto rr = __builtin_amdgcn_permlane32_swap(__float_as_uint(v), __float_as_uint(v), false, false); return __uint_as_float(rr[0]) + __uint_as_float(rr[1]); }
DI float max_xor32(float v) { auto rr = __builtin_amdgcn_permlane32_swap(__float_as_uint(v), __float_as_uint(v), false, false); return fmaxf(__uint_as_float(rr[0]), __uint_as_float(rr[1])); }
DI float wave_sum(float v) {
    v += lane_xor<1>(v); v += lane_xor<2>(v); v += lane_xor<4>(v); v += lane_xor<8>(v); v += lane_xor<16>(v);
    return sum_xor32(v);
}
DI float sigmoidf_fast(float x) { return __builtin_amdgcn_rcpf(1.0f + __builtin_amdgcn_exp2f(-1.4426950408889634f * x)); }
DI float row_rstd(const float* ssq, int row, int fq) {
    const f32x4 v = *(const GAS f32x4*)(ssq + (size_t)row * 16 + 4 * fq);
    float s = (v.x + v.y) + (v.z + v.w);
    s += lane_xor<16>(s); s = sum_xor32(s);
    return 1.0f / sqrtf(s * (1.0f / 1024.0f) + 1e-6f);
}

typedef const f32x4 (&AccRef)[2][2][4][2];
#define EPI_ROWS_BEGIN _Pragma("unroll") for (int ai = 0; ai < 2; ++ai) _Pragma("unroll") for (int m = 0; m < 4; ++m) { const int lrow = u.pm * 256 + ai * 128 + wr * 64 + m * 16 + fr;
#define EPI_COLS_BEGIN _Pragma("unroll") for (int bj = 0; bj < 2; ++bj) { const int col = u.pn * 256 + bj * 128 + wc * 32 + 8 * fq; f32x4 v0 = acc[ai][bj][m][0], v1 = acc[ai][bj][m][1];
#define EPI_END }
#define EPI_ROW_END }
#define EPI_PRELOAD_RSTD(ssqptr) float rs8[8]; { f32x4 q8_[8]; \
    _Pragma("unroll") for (int ai = 0; ai < 2; ++ai) _Pragma("unroll") for (int m = 0; m < 4; ++m) q8_[ai * 4 + m] = *(const GAS f32x4*)((ssqptr) + (size_t)(u.pm * 256 + ai * 128 + wr * 64 + m * 16 + fr) * 16 + 4 * fq); \
    asm volatile("" ::: "memory");     \
    _Pragma("unroll") for (int i_ = 0; i_ < 8; ++i_) { float s_ = (q8_[i_].x + q8_[i_].y) + (q8_[i_].z + q8_[i_].w); s_ += lane_xor<16>(s_); s_ = sum_xor32(s_); rs8[i_] = 1.0f / sqrtf(s_ * (1.0f / 1024.0f) + 1e-6f); } } \
    asm volatile("" ::: "memory");

struct EpiIn {
    static constexpr bool PERM = true, AFTER_DRAIN = false;
    bf16_t* Z; const float* ssq; const float* rope; bf16_t* dummy; int ldz, kind_force;
    DI void operator()(AccRef acc, const pg8::Unit& u, int wr, int wc, int, int) const {
        const int lane_ = lane_id_opaque(), fr = lane_ & 15, fq = lane_ >> 4;
        const int pn = u.pn;
        const int kind = dummy ? 2 : (kind_force >= 0 ? kind_force : (pn < 6 ? (pn < 3 ? 0 : 1) : (pn < 15 ? 2 : (pn < 19 ? 3 : 4))));
        const bool rot = (kind < 2) && ((wc & 1) == 0);
        const float qs = (kind == 0) ? 0.125f : 1.0f;
        EPI_PRELOAD_RSTD(ssq)
#pragma unroll
        for (int ai = 0; ai < 2; ++ai) {
        f32x4 rc0[4], rc1[4], rs0[4], rs1[4];
#pragma unroll
        for (int m = 0; m < 4; ++m) { rc0[m] = (f32x4){1.f, 1.f, 1.f, 1.f}; rc1[m] = rc0[m]; rs0[m] = (f32x4){0.f, 0.f, 0.f, 0.f}; rs1[m] = rs0[m]; }
        if (rot) {
#pragma unroll
            for (int m = 0; m < 4; ++m) { const GAS f32x4* rp = (const GAS f32x4*)(rope + (size_t)(u.pm * 256 + ai * 128 + wr * 64 + m * 16 + fr) * 16); rc0[m] = rp[0]; rc1[m] = rp[1]; rs0[m] = rp[2]; rs1[m] = rp[3]; }
        }
        asm volatile("" ::: "memory");
#pragma unroll
        for (int m = 0; m < 4; ++m) { const int lrow = u.pm * 256 + ai * 128 + wr * 64 + m * 16 + fr;
            const float rs = rs8[ai * 4 + m];
            const f32x4 c0 = rc0[m], c1 = rc1[m], s0 = rs0[m], s1 = rs1[m];
            EPI_COLS_BEGIN
                { const float rsk = (kind == 4) ? rs * -1.4426950408889634f : rs; v0 = v0 * rsk; v1 = v1 * rsk; }
                if (kind < 2) {
                    if (rot) {
                        f32x4 p0, p1;
#pragma unroll
                        for (int e = 0; e < 4; ++e) { p0[e] = lane_xor<16>(v0[e]); p1[e] = lane_xor<16>(v1[e]); }
                        if (fq == 0) { v0 = v0 * c0 - p0 * s0; v1 = v1 * c1 - p1 * s1; }
                        else if (fq == 1) { v0 = v0 * c0 + p0 * s0; v1 = v1 * c1 + p1 * s1; }
                    }
                    v0 = v0 * qs; v1 = v1 * qs;
                } else if (kind == 3) {
                    f32x2 a = pg8::gelu_pk((f32x2){v0[0], v0[1]}), b = pg8::gelu_pk((f32x2){v0[2], v0[3]}), c = pg8::gelu_pk((f32x2){v1[0], v1[1]}), d = pg8::gelu_pk((f32x2){v1[2], v1[3]});
                    v0 = (f32x4){a.x, a.y, b.x, b.y}; v1 = (f32x4){c.x, c.y, d.x, d.y};
                } else if (kind == 4) {
#pragma unroll
                    for (int e = 0; e < 4; ++e) { v0[e] = __builtin_amdgcn_rcpf(1.0f + __builtin_amdgcn_exp2f(v0[e])); v1[e] = __builtin_amdgcn_rcpf(1.0f + __builtin_amdgcn_exp2f(v1[e])); }
                }
                u32x4 w; w.x = cvt_pk_bf16(v0[0], v0[1]); w.y = cvt_pk_bf16(v0[2], v0[3]); w.z = cvt_pk_bf16(v1[0], v1[1]); w.w = cvt_pk_bf16(v1[2], v1[3]);
                *(GAS u32x4*)(dummy ? dummy + lane_ * 8 : Z + (size_t)lrow * ldz + col) = w;
            EPI_END
        }
        }
    }
};
struct EpiGate {
    static constexpr bool PERM = true, AFTER_DRAIN = false, HAS_LOADS = true;
    const bf16_t* G; bf16_t* Mo; int has_prev; bf16_t* dummy;
    DI void operator()(AccRef acc, const pg8::Unit& u, int wr, int wc, int, int) const {
        const int lane_ = lane_id_opaque(), fr = lane_ & 15, fq = lane_ >> 4;
#pragma unroll
        for (int ai = 0; ai < 2; ++ai) {
            u32x4 gq[4][2], pq[4][2];
#pragma unroll
            for (int m = 0; m < 4; ++m)
#pragma unroll
                for (int bj = 0; bj < 2; ++bj) {
                    const int lrow = u.pm * 256 + ai * 128 + wr * 64 + m * 16 + fr, col = u.pn * 256 + bj * 128 + wc * 32 + 8 * fq;
                    gq[m][bj] = *(const GAS u32x4*)(G + (size_t)lrow * DM + col);
                    pq[m][bj] = (u32x4){0u, 0u, 0u, 0u};
                    if (has_prev) pq[m][bj] = *(const GAS u32x4*)(Mo + (size_t)lrow * ZW + col);
                }
            asm volatile("" ::: "memory");
#pragma unroll
            for (int m = 0; m < 4; ++m) {
                const int lrow = u.pm * 256 + ai * 128 + wr * 64 + m * 16 + fr;
                EPI_COLS_BEGIN
                    const size_t off = (size_t)lrow * ZW + col;
                    const u32x4 g = gq[m][bj], p = pq[m][bj];
                    v0[0] = v0[0] * bf_lo(g.x) + bf_lo(p.x); v0[1] = v0[1] * bf_hi(g.x) + bf_hi(p.x); v0[2] = v0[2] * bf_lo(g.y) + bf_lo(p.y); v0[3] = v0[3] * bf_hi(g.y) + bf_hi(p.y);
                    v1[0] = v1[0] * bf_lo(g.z) + bf_lo(p.z); v1[1] = v1[1] * bf_hi(g.z) + bf_hi(p.z); v1[2] = v1[2] * bf_lo(g.w) + bf_lo(p.w); v1[3] = v1[3] * bf_hi(g.w) + bf_hi(p.w);
                    u32x4 w; w.x = cvt_pk_bf16(v0[0], v0[1]); w.y = cvt_pk_bf16(v0[2], v0[3]); w.z = cvt_pk_bf16(v1[0], v1[1]); w.w = cvt_pk_bf16(v1[2], v1[3]);
                    *(GAS u32x4*)(dummy ? dummy + lane_ * 8 : Mo + off) = w;
                EPI_END
            }
        }
    }
};
struct EpiRes {
    static constexpr bool PERM = true, AFTER_DRAIN = false, HAS_LOADS = true;
    const bf16_t* Hin; bf16_t* Hout; float* ssq_out; float* dummy;
    DI void operator()(AccRef acc, const pg8::Unit& u, int wr, int wc, int, int) const {
        const int lane_ = lane_id_opaque(), fr = lane_ & 15, fq = lane_ >> 4;
        u32x4 hv[2][4][2];
#pragma unroll
        for (int ai = 0; ai < 2; ++ai)
#pragma unroll
            for (int m = 0; m < 4; ++m)
#pragma unroll
                for (int bj = 0; bj < 2; ++bj)
                    hv[ai][m][bj] = *(const GAS u32x4*)(Hin + (size_t)(u.pm * 256 + ai * 128 + wr * 64 + m * 16 + fr) * DM + u.pn * 256 + bj * 128 + wc * 32 + 8 * fq);
        asm volatile("" ::: "memory");
        EPI_ROWS_BEGIN
            float ss = 0.f;
            EPI_COLS_BEGIN
                const size_t off = (size_t)lrow * DM + col;
                const u32x4 h4 = hv[ai][m][bj];
                v0[0] += bf_lo(h4.x); v0[1] += bf_hi(h4.x); v0[2] += bf_lo(h4.y); v0[3] += bf_hi(h4.y);
                v1[0] += bf_lo(h4.z); v1[1] += bf_hi(h4.z); v1[2] += bf_lo(h4.w); v1[3] += bf_hi(h4.w);
                ss += (v0[0] * v0[0] + v0[1] * v0[1]) + (v0[2] * v0[2] + v0[3] * v0[3]) + (v1[0] * v1[0] + v1[1] * v1[1]) + (v1[2] * v1[2] + v1[3] * v1[3]);
                u32x4 w; w.x = cvt_pk_bf16(v0[0], v0[1]); w.y = cvt_pk_bf16(v0[2], v0[3]); w.z = cvt_pk_bf16(v1[0], v1[1]); w.w = cvt_pk_bf16(v1[2], v1[3]);
                *(GAS u32x4*)(dummy ? (bf16_t*)(dummy + 2048) + lane_ * 8 : Hout + off) = w;
            EPI_END
            ss += lane_xor<16>(ss); ss = sum_xor32(ss);
            if (fq == 0) *(GAS float*)(dummy ? dummy + 4096 + lane_ : ssq_out + (size_t)lrow * 16 + u.pn * 4 + wc) = ss;
        EPI_ROW_END
    }
};
struct EpiUp {
    static constexpr bool PERM = true, AFTER_DRAIN = false;
    bf16_t* U; const float* ssq;
    DI void operator()(AccRef acc, const pg8::Unit& u, int wr, int wc, int, int) const {
        const int lane_ = lane_id_opaque(), fr = lane_ & 15, fq = lane_ >> 4;
        EPI_PRELOAD_RSTD(ssq)
        EPI_ROWS_BEGIN
            const float rs = rs8[ai * 4 + m];
            EPI_COLS_BEGIN
                {
                    const f32x4 z4 = {0.f, 0.f, 0.f, 0.f}; const float rs2 = rs * rs;
                    const f32x4 m0 = __builtin_elementwise_max(v0, z4), m1 = __builtin_elementwise_max(v1, z4);
                    v0 = (v0 * m0) * rs2; v1 = (v1 * m1) * rs2;
                }
                u32x4 w; w.x = cvt_pk_bf16(v0[0], v0[1]); w.y = cvt_pk_bf16(v0[2], v0[3]); w.z = cvt_pk_bf16(v1[0], v1[1]); w.w = cvt_pk_bf16(v1[2], v1[3]);
                *(GAS u32x4*)(U + (size_t)lrow * UP + col) = w;
            EPI_END
        EPI_ROW_END
    }
};
struct EpiPlain {
    static constexpr bool PERM = true, AFTER_DRAIN = false;
    bf16_t* O; int ldc;
    DI void operator()(AccRef acc, const pg8::Unit& u, int wr, int wc, int, int) const {
        const int lane_ = lane_id_opaque(), fr = lane_ & 15, fq = lane_ >> 4;
        EPI_ROWS_BEGIN
            EPI_COLS_BEGIN
                u32x4 w; w.x = cvt_pk_bf16(v0[0], v0[1]); w.y = cvt_pk_bf16(v0[2], v0[3]); w.z = cvt_pk_bf16(v1[0], v1[1]); w.w = cvt_pk_bf16(v1[2], v1[3]);
                *(GAS u32x4*)(O + (size_t)lrow * ldc + col) = w;
            EPI_END
        EPI_ROW_END
    }
};
struct EpiPle {
    static constexpr bool PERM = true, AFTER_DRAIN = false, HAS_LOADS = true;
    const bf16_t* Hin; const bf16_t* PP; const float* ssq; bf16_t* Hout; float* ssq_out; float* dummy;
    DI void operator()(AccRef acc, const pg8::Unit& u, int wr, int wc, int, int) const {
        const int lane_ = lane_id_opaque(), fr = lane_ & 15, fq = lane_ >> 4;
        EPI_PRELOAD_RSTD(ssq)
#pragma unroll
        for (int ai = 0; ai < 2; ++ai) {
            u32x4 hq[4][2];
#pragma unroll
            for (int m = 0; m < 4; ++m)
#pragma unroll
                for (int bj = 0; bj < 2; ++bj)
                    hq[m][bj] = *(const GAS u32x4*)(Hin + (size_t)(u.pm * 256 + ai * 128 + wr * 64 + m * 16 + fr) * DM + u.pn * 256 + bj * 128 + wc * 32 + 8 * fq);
            asm volatile("" ::: "memory");
#pragma unroll
            for (int mp = 0; mp < 2; ++mp) {
                u32x4 gq[2][2];
#pragma unroll
                for (int mm = 0; mm < 2; ++mm)
#pragma unroll
                    for (int bj = 0; bj < 2; ++bj)
                        gq[mm][bj] = *(const GAS u32x4*)(PP + (size_t)(u.pm * 256 + ai * 128 + wr * 64 + (2 * mp + mm) * 16 + fr) * DM + u.pn * 256 + bj * 128 + wc * 32 + 8 * fq);
                asm volatile("" ::: "memory");
#pragma unroll
                for (int mm = 0; mm < 2; ++mm) {
                    const int m = 2 * mp + mm;
                    const int lrow = u.pm * 256 + ai * 128 + wr * 64 + m * 16 + fr;
                    const float rs = rs8[ai * 4 + m];
                    float ss = 0.f;
                    EPI_COLS_BEGIN
                        const size_t off = (size_t)lrow * DM + col;
                        const u32x4 g = gq[mm][bj], hv = hq[m][bj];
                        v0[0] = bf_lo(hv.x) + sigmoidf_fast(v0[0] * rs) * bf_lo(g.x); v0[1] = bf_hi(hv.x) + sigmoidf_fast(v0[1] * rs) * bf_hi(g.x);
                        v0[2] = bf_lo(hv.y) + sigmoidf_fast(v0[2] * rs) * bf_lo(g.y); v0[3] = bf_hi(hv.y) + sigmoidf_fast(v0[3] * rs) * bf_hi(g.y);
                        v1[0] = bf_lo(hv.z) + sigmoidf_fast(v1[0] * rs) * bf_lo(g.z); v1[1] = bf_hi(hv.z) + sigmoidf_fast(v1[1] * rs) * bf_hi(g.z);
                        v1[2] = bf_lo(hv.w) + sigmoidf_fast(v1[2] * rs) * bf_lo(g.w); v1[3] = bf_hi(hv.w) + sigmoidf_fast(v1[3] * rs) * bf_hi(g.w);
                        ss += (v0[0] * v0[0] + v0[1] * v0[1]) + (v0[2] * v0[2] + v0[3] * v0[3]) + (v1[0] * v1[0] + v1[1] * v1[1]) + (v1[2] * v1[2] + v1[3] * v1[3]);
                        u32x4 w; w.x = cvt_pk_bf16(v0[0], v0[1]); w.y = cvt_pk_bf16(v0[2], v0[3]); w.z = cvt_pk_bf16(v1[0], v1[1]); w.w = cvt_pk_bf16(v1[2], v1[3]);
                        *(GAS u32x4*)(dummy ? (bf16_t*)(dummy + 2048) + lane_ * 8 : Hout + off) = w;
                    EPI_END
                    ss += lane_xor<16>(ss); ss = sum_xor32(ss);
                    if (fq == 0) *(GAS float*)(dummy ? dummy + 4096 + lane_ : ssq_out + (size_t)lrow * 16 + u.pn * 4 + wc) = ss;
                }
            }
        }
    }
};

template <class Epi>
DI void run_gemm(LAS unsigned char* lds, int bid, int gsz, int wave, const bf16_t* A, int lda, const bf16_t* Bt, int M, int N, int K, const Epi& E, int ldb = 0) {
    if (ldb == 0) ldb = K;
    pg8::Gemm g{A, lda, Bt, ldb, M, N, K, wave};
    pg8::StaticOrder S; S.init(M, N, gsz, bid);
    pg8::gemm_phase<Epi, pg8::StaticOrder, true, true>(lds, g, S, E);
}

DI void transpose_item(const float* W_, int K, int N, bf16_t* WT, int ldk, int koff, const float* gk_, LAS float* scr, int item, int lane) {
    const GAS float* W = (const GAS float*)W_; const GAS float* gk = (const GAS float*)gk_;
    const int nblk = N / 32, kb = item / nblk, nb = item % nblk, k0 = 64 * kb, n0 = 32 * nb;
    float wv_[32];
#pragma unroll
    for (int i = 0; i < 32; ++i) wv_[i] = __builtin_nontemporal_load(W + (size_t)(k0 + 2 * i + (lane >> 5)) * N + n0 + (lane & 31));
#pragma unroll
    for (int i = 0; i < 32; ++i) { const int kk = 2 * i + (lane >> 5); float v = wv_[i]; if (gk) v *= gk[k0 + kk]; scr[kk * 33 + (lane & 31)] = v; }
    asm volatile("s_waitcnt lgkmcnt(0)" ::: "memory");
    const int c = lane & 7;
#pragma unroll
    for (int j = 0; j < 4; ++j) { const int n = (lane >> 3) + 8 * j; const LAS float* s = scr + (8 * c) * 33 + n;
        u32x4 o; o.x = cvt_pk_bf16(s[0 * 33], s[1 * 33]); o.y = cvt_pk_bf16(s[2 * 33], s[3 * 33]); o.z = cvt_pk_bf16(s[4 * 33], s[5 * 33]); o.w = cvt_pk_bf16(s[6 * 33], s[7 * 33]);
        *(GAS u32x4*)(WT + (size_t)(n0 + n) * ldk + koff + k0 + 8 * c) = o; }
    asm volatile("s_waitcnt lgkmcnt(0)" ::: "memory");
}

constexpr int ARG_OFF = 131072;
DI const void* argp(LAS unsigned char* lds, int k) {
    unsigned a_ = ARG_OFF; asm volatile("" : "+s"(a_));
    const unsigned long long v = ((const LAS unsigned long long*)(lds + a_))[k];
    const unsigned lo = __builtin_amdgcn_readfirstlane((unsigned)v), hi = __builtin_amdgcn_readfirstlane((unsigned)(v >> 32));
    return (const void*)(((unsigned long long)hi << 32) | lo);
}
struct Ctx {
    LAS unsigned char* lds; unsigned char* ws; int tid, lane, wave, gw, ngw, bid, gsz;
};

DI void phase_prologue(const Ctx& C) {
    const GAS float* x = (const GAS float*)argp(C.lds, 0); const GAS int* pos = (const GAS int*)argp(C.lds, 2);
    GAS bf16_t* hbB = (GAS bf16_t*)(C.ws + WS_HBB); GAS float* ssqC = (GAS float*)(C.ws + WS_SSQC); GAS float* rope = (GAS float*)(C.ws + WS_ROPE);
    for (int m0 = C.gw; m0 < MTOK; m0 += 4 * C.ngw) {
        f32x4 v[4][4];
#pragma unroll
        for (int k = 0; k < 4; ++k) { const int m = m0 + k * C.ngw; if (m < MTOK) { const GAS f32x4* xr = (const GAS f32x4*)(x + (size_t)m * DM) + C.lane;
#pragma unroll
            for (int j = 0; j < 4; ++j) v[k][j] = __builtin_nontemporal_load(xr + 64 * j); } }
#pragma unroll
        for (int k = 0; k < 4; ++k) { const int m = m0 + k * C.ngw; if (m < MTOK) {
            GAS u32x2* br = (GAS u32x2*)(hbB + (size_t)m * DM) + C.lane; float s = 0.f;
#pragma unroll
            for (int j = 0; j < 4; ++j) { const f32x4 t = v[k][j]; s += (t.x * t.x + t.y * t.y) + (t.z * t.z + t.w * t.w);
                u32x2 w; w.x = cvt_pk_bf16(t.x, t.y); w.y = cvt_pk_bf16(t.z, t.w); br[64 * j] = w; }
            s = wave_sum(s);
            if (C.lane < 16) ssqC[(size_t)m * 16 + C.lane] = (C.lane == 0) ? s : 0.f; } }
    }
    const int gt = C.gw * 64 + C.lane, ngt = C.ngw * 64;
    for (int tok = gt; tok < MTOK; tok += ngt) {
        const float pf = (float)pos[tok];
#pragma unroll
        for (int j = 0; j < 8; ++j) {
            const float ang = __fmul_rn(pf, ((const LAS float*)(C.lds + ARG_OFF + 23 * 8))[j]);
            const double rev = (double)ang * 0.15915494309189535; const float frc = (float)(rev - __builtin_rint(rev));
            rope[(size_t)tok * 16 + j] = __builtin_amdgcn_cosf(frc); rope[(size_t)tok * 16 + 8 + j] = __builtin_amdgcn_sinf(frc);
        }
    }
}

DI void phase_convert(const Ctx& C, int L) {
    LAS float* scr = (LAS float*)(C.lds + C.wave * 16384);
    const float* w_in = (const float*)argp(C.lds, 4) + (size_t)L * DM * INW; const float* g_mix = (const float*)argp(C.lds, 3) + L * DM;
    const float* w_ba = (const float*)argp(C.lds, 10) + (size_t)L * 768 * DM; const float* w_bb = (const float*)argp(C.lds, 11) + (size_t)L * 512 * DM; const float* w_bc = (const float*)argp(C.lds, 12) + (size_t)L * 512 * DM;
    const float* w_out = (const float*)argp(C.lds, 13) + (size_t)L * DM * DM;
    const float* w_up = (const float*)argp(C.lds, 15) + (size_t)L * DM * DFF; const float* g_mlp = (const float*)argp(C.lds, 14) + L * DM;
    const float* w_down = (const float*)argp(C.lds, 16) + (size_t)L * DFF * DM;
    const float* w_pg = (const float*)argp(C.lds, 18) + (size_t)L * DM * DM; const float* g_ple = (const float*)argp(C.lds, 17) + L * DM;
    const float* w_pe = (const float*)argp(C.lds, 19) + (size_t)L * PLE * DM;
    constexpr int I_IN = 16 * (INW / 32), I_BA = 12 * 32, I_BB = 8 * 32, I_OUT = 16 * 32, I_UP = 16 * (DFF / 32), I_DOWN = 64 * 32, I_PG = 16 * 32, I_PE = 4 * 32;
    constexpr int NITEMS = I_IN + I_BA + 2 * I_BB + I_OUT + I_UP + I_DOWN + I_PG + I_PE;
    for (int it = C.gw; it < NITEMS; it += C.ngw) {
        int r = it;
        if (r < I_IN) { transpose_item(w_in, DM, INW, (bf16_t*)(C.ws + WS_WIN), DM, 0, g_mix, scr, r, C.lane); continue; } r -= I_IN;
        if (r < I_BA) { transpose_item(w_ba, 768, DM, (bf16_t*)(C.ws + WS_WBA), 768, 0, nullptr, scr, r, C.lane); continue; } r -= I_BA;
        if (r < I_BB) { transpose_item(w_bb, 512, DM, (bf16_t*)(C.ws + WS_WBB), 512, 0, nullptr, scr, r, C.lane); continue; } r -= I_BB;
        if (r < I_BB) { transpose_item(w_bc, 512, DM, (bf16_t*)(C.ws + WS_WBC), 512, 0, nullptr, scr, r, C.lane); continue; } r -= I_BB;
        if (r < I_OUT) { transpose_item(w_out, DM, DM, (bf16_t*)(C.ws + WS_WOUT3), DM, 0, nullptr, scr, r, C.lane); continue; } r -= I_OUT;
        if (r < I_UP) { transpose_item(w_up, DM, DFF, (bf16_t*)(C.ws + WS_WUP), DM, 0, g_mlp, scr, r, C.lane); continue; } r -= I_UP;
        if (r < I_DOWN) { transpose_item(w_down, DFF, DM, (bf16_t*)(C.ws + WS_WDOWN), UP, 0, nullptr, scr, r, C.lane); continue; } r -= I_DOWN;
        if (r < I_PG) { transpose_item(w_pg, DM, DM, (bf16_t*)(C.ws + WS_WPG), DM, 0, g_ple, scr, r, C.lane); continue; } r -= I_PG;
        transpose_item(w_pe, PLE, DM, (bf16_t*)(C.ws + WS_WPE), PLE, 0, nullptr, scr, r, C.lane);
    }
    const int gt = C.gw * 64 + C.lane, ngt = C.ngw * 64;
    const float* p = (const float*)argp(C.lds, 1) + (size_t)L * MTOK * PLE; bf16_t* pbf = (bf16_t*)(C.ws + WS_PBF);
    for (int i = gt; i < MTOK * PLE / 8; i += ngt) {
        const f32x4 a = *(const GAS f32x4*)(p + (size_t)i * 8), b = *(const GAS f32x4*)(p + (size_t)i * 8 + 4);
        u32x4 w; w.x = cvt_pk_bf16(a.x, a.y); w.y = cvt_pk_bf16(a.z, a.w); w.z = cvt_pk_bf16(b.x, b.y); w.w = cvt_pk_bf16(b.z, b.w);
        *(GAS u32x4*)(pbf + (size_t)i * 8) = w;
    }
    const GAS float* sgw = (const GAS float*)argp(C.lds, 8) + (size_t)L * 4 * 128 * 128; bf16_t* sgb = (bf16_t*)(C.ws + WS_SGW);
    for (int i = gt; i < 4 * 128 * 128 / 2; i += ngt) {
        const int e = i * 2, s = e & 127, t = (e >> 7) & 127;
        const float a = (s <= t) ? sgw[e] : 0.f, b = (s + 1 <= t) ? sgw[e + 1] : 0.f;
        *(GAS unsigned*)(sgb + e) = cvt_pk_bf16(a, b);
    }
}

DI void phase_attn(const Ctx& C, bf16_t* Z, float* lse, bool dry) {
    const int tid = C.tid, lane = C.lane, w = C.wave, fr = lane & 15, fq = lane >> 4;
    LAS bf16_t* Ks = (LAS bf16_t*)C.lds;
    LAS bf16_t* Vt = (LAS bf16_t*)(C.lds + 36864);
    const int upc = 3072 / C.gsz, urem = 3072 - upc * C.gsz, nmine = upc + (C.bid < urem ? 1 : 0);
    int cslot = 1;
    for (int ui = 0; ui < nmine; ++ui) {
        const int uid = ui < upc ? C.bid * upc + ui : C.gsz * upc + C.bid;
        const int j = uid & 31, head = (uid >> 5) % 12, bl = uid / 384;
        const int g = head >> 2, dsh = 2 * g, nsh = 5 - dsh;
        const int r = j >> nsh, n = j & ((1 << nsh) - 1);
        const size_t rowb = (size_t)bl * SEQ + r;
        const bool reuse = (ui > 0) && (ui < upc) && (n > 0);
        cslot = reuse ? (cslot ^ 1) : 1;
        const int rot = 128 * (1 - cslot), rot16 = rot >> 4;
#pragma unroll
        for (int cc = 0; cc < 4; ++cc) {
            if (cc < 2 && reuse) continue;
            const int c = tid + cc * 512, kj = c >> 3, ch = c & 7, mm = (n - 1) * 128 + kj, pk = (kj + rot) & 255;
            u32x4 kv = {0u, 0u, 0u, 0u}, vv = {0u, 0u, 0u, 0u};
            if (mm >= 0) { const bf16_t* p = Z + (rowb + ((size_t)mm << dsh)) * ZW + head * 64 + ch * 8; kv = __builtin_nontemporal_load((const GAS u32x4*)(p + CK)); vv = __builtin_nontemporal_load((const GAS u32x4*)(p + CV)); }
            *(LAS u32x4*)(Ks + pk * 72 + ch * 8) = kv;
            LAS bf16_t* vp = Vt + (ch * 8) * 264 + (pk ^ (ch << 3));
            vp[0 * 264] = (bf16_t)(vv.x & 0xffffu); vp[1 * 264] = (bf16_t)(vv.x >> 16);
            vp[2 * 264] = (bf16_t)(vv.y & 0xffffu); vp[3 * 264] = (bf16_t)(vv.y >> 16);
            vp[4 * 264] = (bf16_t)(vv.z & 0xffffu); vp[5 * 264] = (bf16_t)(vv.z >> 16);
            vp[6 * 264] = (bf16_t)(vv.w & 0xffffu); vp[7 * 264] = (bf16_t)(vv.w >> 16);
        }
        const int qi = 16 * w + fr; const size_t qrow = rowb + ((size_t)(n * 128 + qi) << dsh);
        bf16_t* qp = Z + qrow * ZW + head * 64;
        const bf16x8 qf0 = __builtin_nontemporal_load((const GAS bf16x8*)(qp + 8 * fq)), qf1 = __builtin_nontemporal_load((const GAS bf16x8*)(qp + 32 + 8 * fq));
        __syncthreads();
        const int t0 = w < 6 ? w : 6;
        f32x4 st[10];
#pragma unroll
        for (int x = 0; x < 10; ++x) {
            const LAS bf16_t* kp = Ks + (16 * ((t0 + x + rot16) & 15) + fr) * 72 + 8 * fq;
            const bf16x8 a0 = *(const LAS bf16x8*)kp, a1 = *(const LAS bf16x8*)(kp + 32);
            f32x4 acc = {0.f, 0.f, 0.f, 0.f};
            acc = __builtin_amdgcn_mfma_f32_16x16x32_bf16(a0, qf0, acc, 0, 0, 0);
            acc = __builtin_amdgcn_mfma_f32_16x16x32_bf16(a1, qf1, acc, 0, 0, 0);
            st[x] = acc;
        }
        float mx = -INFINITY;
#pragma unroll
        for (int x = 0; x < 10; ++x)
#pragma unroll
            for (int i = 0; i < 4; ++i) {
                const int kj = 16 * (t0 + x) + 4 * fq + i, dist = qi + 128 - kj;
                const bool valid = (dist >= 0) && (dist <= 128) && (n > 0 || kj >= 128);
                const float s = valid ? st[x][i] : -INFINITY; st[x][i] = s; mx = fmaxf(mx, s);
            }
        mx = fmaxf(mx, lane_xor<16>(mx)); mx = max_xor32(mx);
        float sum = 0.f;
#pragma unroll
        for (int x = 0; x < 10; ++x)
#pragma unroll
            for (int i = 0; i < 4; ++i) { const float p = __builtin_amdgcn_exp2f((st[x][i] - mx) * 1.4426950408889634f); st[x][i] = p; sum += p; }
        sum += lane_xor<16>(sum); sum = sum_xor32(sum);
        f32x4 o[4];
#pragma unroll
        for (int dt = 0; dt < 4; ++dt) o[dt] = (f32x4){0.f, 0.f, 0.f, 0.f};
#pragma unroll
        for (int y = 0; y < 5; ++y) {
            u32x4 pw; pw.x = cvt_pk_bf16(st[2 * y][0], st[2 * y][1]); pw.y = cvt_pk_bf16(st[2 * y][2], st[2 * y][3]);
            pw.z = cvt_pk_bf16(st[2 * y + 1][0], st[2 * y + 1][1]); pw.w = cvt_pk_bf16(st[2 * y + 1][2], st[2 * y + 1][3]);
            const bf16x8 pb = __builtin_bit_cast(bf16x8, pw);
            const int ka = 16 * ((t0 + 2 * y + rot16) & 15) + 4 * fq, kb = 16 * ((t0 + 2 * y + 1 + rot16) & 15) + 4 * fq;
#pragma unroll
            for (int dt = 0; dt < 4; ++dt) {
                const LAS bf16_t* vr = Vt + (16 * dt + fr) * 264; const int sw = ((2 * dt + (fr >> 3)) & 7) << 3;
                const s16x4 va = *(const LAS s16x4*)(vr + (ka ^ sw)), vb = *(const LAS s16x4*)(vr + (kb ^ sw));
                const bf16x8 a = {va[0], va[1], va[2], va[3], vb[0], vb[1], vb[2], vb[3]};
                o[dt] = __builtin_amdgcn_mfma_f32_16x16x32_bf16(a, pb, o[dt], 0, 0, 0);
            }
        }
        const float inv = 1.0f / sum;
        bf16_t* qst = dry ? (bf16_t*)(C.ws + WS_PP) + tid * 64 : qp;
#pragma unroll
        for (int dt = 0; dt < 4; ++dt) {
            u32x2 wv; wv.x = cvt_pk_bf16(o[dt][0] * inv, o[dt][1] * inv); wv.y = cvt_pk_bf16(o[dt][2] * inv, o[dt][3] * inv);
            *(GAS u32x2*)(qst + 16 * dt + 4 * fq) = wv;
        }
        if (fq == 0) *(GAS float*)(dry ? (float*)(C.ws + WS_PP) + 1048576 + tid : lse + qrow * 12 + head) = mx + __builtin_amdgcn_logf(sum) * 0.6931471805599453f;
        __syncthreads();
    }
}

DI void phase_mix(const Ctx& C, bf16_t* Z, const float* lse_, int L, bool dry) {
    const GAS float* lse = (const GAS float*)lse_;
    bf16_t* dummy = (bf16_t*)(C.ws + WS_PP) + C.tid * 64;
    const int gt = C.bid * 512 + C.tid, ngt = C.gsz * 512;
    for (int base = gt; base < MTOK * 96; base += 8 * ngt) {
        u32x4 v[8]; float l0[8], l1[8], l2[8];
#pragma unroll
        for (int k = 0; k < 8; ++k) {
            const int idx = base + k * ngt;
            if (idx < MTOK * 96) {
                const int lrow = idx / 96, rem = idx - lrow * 96, head = rem >> 3, ch = rem & 7, slot = head & 3;
                l0[k] = lse[(size_t)lrow * 12 + slot]; l1[k] = lse[(size_t)lrow * 12 + 4 + slot]; l2[k] = lse[(size_t)lrow * 12 + 8 + slot];
                v[k] = __builtin_nontemporal_load((const GAS u32x4*)(Z + (size_t)lrow * ZW + head * 64 + ch * 8));
            }
        }
#pragma unroll
        for (int k = 0; k < 8; ++k) {
            const int idx = base + k * ngt;
            if (idx < MTOK * 96) {
                const int lrow = idx / 96, rem = idx - lrow * 96, head = rem >> 3, ch = rem & 7, g = head >> 2;
                const float mx = fmaxf(l0[k], fmaxf(l1[k], l2[k]));
                const float e0 = __builtin_amdgcn_exp2f((l0[k] - mx) * 1.4426950408889634f), e1 = __builtin_amdgcn_exp2f((l1[k] - mx) * 1.4426950408889634f), e2 = __builtin_amdgcn_exp2f((l2[k] - mx) * 1.4426950408889634f);
                const float al = (g == 0 ? e0 : (g == 1 ? e1 : e2)) / (e0 + e1 + e2);
                bf16_t* p = Z + (size_t)lrow * ZW + head * 64 + ch * 8;
                u32x4 w;
                w.x = cvt_pk_bf16(bf_lo(v[k].x) * al, bf_hi(v[k].x) * al); w.y = cvt_pk_bf16(bf_lo(v[k].y) * al, bf_hi(v[k].y) * al);
                w.z = cvt_pk_bf16(bf_lo(v[k].z) * al, bf_hi(v[k].z) * al); w.w = cvt_pk_bf16(bf_lo(v[k].w) * al, bf_hi(v[k].w) * al);
                *(GAS u32x4*)(dry ? dummy : p) = w;
            }
        }
    }
    const float* cw = (const float*)argp(C.lds, 5) + (size_t)L * 3 * 512;
    for (int base = gt; base < MTOK * 64; base += 4 * ngt) {
        u32x4 xv[4][3], cv[4][3], bv[4];
#pragma unroll
        for (int k = 0; k < 4; ++k) {
            const int idx = base + k * ngt; const int lrow = idx >> 6, c0 = (idx & 63) * 8, t = lrow & (SEQ - 1);
#pragma unroll
            for (int jj = 0; jj < 3; ++jj) {
                const int back = 2 - jj; xv[k][jj] = (u32x4){0u, 0u, 0u, 0u}; cv[k][jj] = (u32x4){0u, 0u, 0u, 0u};
                if (idx < MTOK * 64 && t >= back) { const bf16_t* zr = Z + (size_t)(lrow - back) * ZW + c0; xv[k][jj] = *(const GAS u32x4*)(zr + CX); cv[k][jj] = *(const GAS u32x4*)(zr + CC); }
            }
            bv[k] = (u32x4){0u, 0u, 0u, 0u};
            if (idx < MTOK * 64) bv[k] = __builtin_nontemporal_load((const GAS u32x4*)(Z + (size_t)lrow * ZW + CB + c0));
        }
#pragma unroll
        for (int k = 0; k < 4; ++k) {
            const int idx = base + k * ngt; const int lrow = idx >> 6, c0 = (idx & 63) * 8;
            if (idx < MTOK * 64) {
                float accv[8];
#pragma unroll
                for (int e = 0; e < 8; ++e) accv[e] = 0.f;
#pragma unroll
                for (int jj = 0; jj < 3; ++jj) {
                    const f32x4 w0 = *(const GAS f32x4*)(cw + jj * 512 + c0), w1 = *(const GAS f32x4*)(cw + jj * 512 + c0 + 4);
                    const u32x4 x_ = xv[k][jj], c_ = cv[k][jj];
                    accv[0] += w0.x * bf_lo(x_.x) * bf_lo(c_.x); accv[1] += w0.y * bf_hi(x_.x) * bf_hi(c_.x);
                    accv[2] += w0.z * bf_lo(x_.y) * bf_lo(c_.y); accv[3] += w0.w * bf_hi(x_.y) * bf_hi(c_.y);
                    accv[4] += w1.x * bf_lo(x_.z) * bf_lo(c_.z); accv[5] += w1.y * bf_hi(x_.z) * bf_hi(c_.z);
                    accv[6] += w1.z * bf_lo(x_.w) * bf_lo(c_.w); accv[7] += w1.w * bf_hi(x_.w) * bf_hi(c_.w);
                }
                bf16_t* bp = Z + (size_t)lrow * ZW + CB + c0;
                u32x4 w;
                w.x = cvt_pk_bf16(bf_lo(bv[k].x) * accv[0], bf_hi(bv[k].x) * accv[1]); w.y = cvt_pk_bf16(bf_lo(bv[k].y) * accv[2], bf_hi(bv[k].y) * accv[3]);
                w.z = cvt_pk_bf16(bf_lo(bv[k].z) * accv[4], bf_hi(bv[k].z) * accv[5]); w.w = cvt_pk_bf16(bf_lo(bv[k].w) * accv[6], bf_hi(bv[k].w) * accv[7]);
                *(GAS u32x4*)(dry ? dummy : bp) = w;
            }
        }
    }
    const int lane = C.lane, w = C.wave, fr = lane & 15, fq = lane >> 4, tid = C.tid;
    LAS bf16_t* Vt2 = (LAS bf16_t*)C.lds;
    LAS float* stat = (LAS float*)(C.lds + 34816);
    const bf16_t* sgw = (const bf16_t*)(C.ws + WS_SGW);
    const float* ln_g = (const float*)argp(C.lds, 6) + L * 512; const float* ln_b = (const float*)argp(C.lds, 7) + L * 512; const GAS float* sg_b = (const GAS float*)argp(C.lds, 9) + L * 512;
    for (int ck = C.bid; ck < MTOK / 128; ck += C.gsz) {
        const int row0 = ck * 128;
        {
            const int tk = tid >> 2, q4 = tid & 3;
            const bf16_t* vr = Z + (size_t)(row0 + tk) * ZW + CVV + q4 * 128;
            float s1 = 0.f, s2 = 0.f;
#pragma unroll
            for (int i = 0; i < 16; ++i) {
                const u32x4 raw = *(const GAS u32x4*)(vr + i * 8);
                const float x0 = bf_lo(raw.x), x1 = bf_hi(raw.x), x2 = bf_lo(raw.y), x3 = bf_hi(raw.y), x4 = bf_lo(raw.z), x5 = bf_hi(raw.z), x6 = bf_lo(raw.w), x7 = bf_hi(raw.w);
                s1 += ((x0 + x1) + (x2 + x3)) + ((x4 + x5) + (x6 + x7));
                s2 += ((x0 * x0 + x1 * x1) + (x2 * x2 + x3 * x3)) + ((x4 * x4 + x5 * x5) + (x6 * x6 + x7 * x7));
            }
            s1 += lane_xor<1>(s1); s1 += lane_xor<2>(s1); s2 += lane_xor<1>(s2); s2 += lane_xor<2>(s2);
            const float mean = s1 * (1.0f / 512.0f), var = fmaxf(s2 * (1.0f / 512.0f) - mean * mean, 0.f);
            if (q4 == 0) { stat[tk * 2] = mean; stat[tk * 2 + 1] = 1.0f / sqrtf(var + 1e-5f); }
        }
        __syncthreads();
        u32x4 raw[4];
#pragma unroll
        for (int cc = 0; cc < 4; ++cc) { const int c = tid + cc * 512, tk = c >> 4, ch = c & 15; raw[cc] = *(const GAS u32x4*)(Z + (size_t)(row0 + tk) * ZW + CVV + ch * 8); }
        for (int g = 0; g < 4; ++g) {
        const int tkE = 16 * w + fr;
        bf16_t* up = Z + (size_t)(row0 + tkE) * ZW + CU + g * 128 + 4 * fq;
        u32x2 uq[8];
#pragma unroll
        for (int ct = 0; ct < 8; ++ct) uq[ct] = __builtin_nontemporal_load((const GAS u32x2*)(up + 16 * ct));
        const float bias = sg_b[g * 128 + tkE];
#pragma unroll
        for (int cc = 0; cc < 4; ++cc) {
            const int c = tid + cc * 512, tk = c >> 4, ch = c & 15, c0 = g * 128 + ch * 8;
            const u32x4 rw = raw[cc];
            const float mean = stat[tk * 2], rstd = stat[tk * 2 + 1];
            const f32x4 g0 = *(const GAS f32x4*)(ln_g + c0), g1 = *(const GAS f32x4*)(ln_g + c0 + 4), b0 = *(const GAS f32x4*)(ln_b + c0), b1 = *(const GAS f32x4*)(ln_b + c0 + 4);
            LAS bf16_t* vp = Vt2 + (ch * 8) * 136 + (tk ^ (ch << 3));
            const unsigned p0 = cvt_pk_bf16((bf_lo(rw.x) - mean) * rstd * g0.x + b0.x, (bf_hi(rw.x) - mean) * rstd * g0.y + b0.y);
            const unsigned p1 = cvt_pk_bf16((bf_lo(rw.y) - mean) * rstd * g0.z + b0.z, (bf_hi(rw.y) - mean) * rstd * g0.w + b0.w);
            const unsigned p2 = cvt_pk_bf16((bf_lo(rw.z) - mean) * rstd * g1.x + b1.x, (bf_hi(rw.z) - mean) * rstd * g1.y + b1.y);
            const unsigned p3 = cvt_pk_bf16((bf_lo(rw.w) - mean) * rstd * g1.z + b1.z, (bf_hi(rw.w) - mean) * rstd * g1.w + b1.w);
            vp[0 * 136] = (bf16_t)(p0 & 0xffffu); vp[1 * 136] = (bf16_t)(p0 >> 16); vp[2 * 136] = (bf16_t)(p1 & 0xffffu); vp[3 * 136] = (bf16_t)(p1 >> 16);
            vp[4 * 136] = (bf16_t)(p2 & 0xffffu); vp[5 * 136] = (bf16_t)(p2 >> 16); vp[6 * 136] = (bf16_t)(p3 & 0xffffu); vp[7 * 136] = (bf16_t)(p3 >> 16);
        }
        __syncthreads();
        if (g < 3) {
#pragma unroll
            for (int cc = 0; cc < 4; ++cc) { const int c = tid + cc * 512, tk = c >> 4, ch = c & 15; raw[cc] = *(const GAS u32x4*)(Z + (size_t)(row0 + tk) * ZW + CVV + (g + 1) * 128 + ch * 8); }
        }
        f32x4 acc[8];
#pragma unroll
        for (int ct = 0; ct < 8; ++ct) acc[ct] = (f32x4){0.f, 0.f, 0.f, 0.f};
        const bf16_t* wrow = sgw + (size_t)(g * 128 + 16 * w + fr) * 128 + 8 * fq;
        const int nks = (w >> 1) + 1;
        for (int ks = 0; ks < nks; ++ks) {
            const bf16x8 bw = *(const GAS bf16x8*)(wrow + 32 * ks);
#pragma unroll
            for (int ct = 0; ct < 8; ++ct) {
                const bf16x8 av = *(const LAS bf16x8*)(Vt2 + (16 * ct + fr) * 136 + ((32 * ks + 8 * fq) ^ (((2 * ct + (fr >> 3)) & 15) << 3)));
                acc[ct] = __builtin_amdgcn_mfma_f32_16x16x32_bf16(av, bw, acc[ct], 0, 0, 0);
            }
        }
#pragma unroll
        for (int ct = 0; ct < 8; ++ct) {
            const u32x2 uv = uq[ct]; u32x2 wv;
            wv.x = cvt_pk_bf16(bf_lo(uv.x) * (acc[ct][0] + bias), bf_hi(uv.x) * (acc[ct][1] + bias));
            wv.y = cvt_pk_bf16(bf_lo(uv.y) * (acc[ct][2] + bias), bf_hi(uv.y) * (acc[ct][3] + bias));
            *(GAS u32x2*)(dry ? dummy + 16 * ct : up + 16 * ct) = wv;
        }
        __syncthreads();
        }
    }
}

DI void phase_final(const Ctx& C) {
    GAS float* out = (GAS float*)argp(C.lds, 21); const GAS bf16_t* hb = (const GAS bf16_t*)(C.ws + WS_HBB); const GAS float* ssqC = (const GAS float*)(C.ws + WS_SSQC); const GAS float* gf = (const GAS float*)argp(C.lds, 20);
    f32x4 g[4];
#pragma unroll
    for (int j = 0; j < 4; ++j) g[j] = ((const GAS f32x4*)gf + C.lane)[64 * j];
    for (int m0 = C.gw; m0 < MTOK; m0 += 4 * C.ngw) {
        u32x2 hv[4][4]; float sq[4];
#pragma unroll
        for (int k = 0; k < 4; ++k) { const int m = m0 + k * C.ngw; sq[k] = 0.f; if (m < MTOK) {
            sq[k] = (C.lane < 16) ? ssqC[(size_t)m * 16 + C.lane] : 0.f;
            const GAS u32x2* hr = (const GAS u32x2*)(hb + (size_t)m * DM) + C.lane;
#pragma unroll
            for (int j = 0; j < 4; ++j) hv[k][j] = __builtin_nontemporal_load(hr + 64 * j); } }
#pragma unroll
        for (int k = 0; k < 4; ++k) { const int m = m0 + k * C.ngw; if (m < MTOK) {
            const float rs = 1.0f / sqrtf(wave_sum(sq[k]) * (1.0f / 1024.0f) + 1e-6f);
            GAS f32x4* orow = (GAS f32x4*)(out + (size_t)m * DM) + C.lane;
#pragma unroll
            for (int j = 0; j < 4; ++j) { const u32x2 h2 = hv[k][j];
                f32x4 v; v.x = bf_lo(h2.x) * rs * g[j].x; v.y = bf_hi(h2.x) * rs * g[j].y; v.z = bf_lo(h2.y) * rs * g[j].z; v.w = bf_hi(h2.y) * rs * g[j].w; orow[64 * j] = v; } } }
    }
}

#define XB_TMO      128
#define XB_XCNT(j)  (256  + 64 * (j))
#define XB_XSUB(j)  (1280 + 64 * (j))
#define XB_XGEN(j)  (2304 + 64 * (j))
#define XB_TOP      3328
#define XB_TOPGEN   3392
#define XCD_BAR_WORDS 3456
#define XB_SPIN_CAP (1u << 18)

__device__ __forceinline__ unsigned xb_ld(unsigned* p)              { return __hip_atomic_load(p, __ATOMIC_RELAXED, __HIP_MEMORY_SCOPE_AGENT); }
__device__ __forceinline__ unsigned xb_add(unsigned* p, unsigned v) { return __hip_atomic_fetch_add(p, v, __ATOMIC_RELAXED, __HIP_MEMORY_SCOPE_AGENT); }
__device__ __forceinline__ unsigned xb_xcc_id() { return (unsigned)__builtin_amdgcn_s_getreg((3 << 11) | 20) & 0xFu; }
#define XB_SPIN(cond, bar) do { unsigned _sp = 0; while (cond) { __builtin_amdgcn_s_sleep(1); \
    if ((++_sp & 255u) == 0u) { if (xb_ld(&(bar)[XB_TMO])) break; if (_sp > XB_SPIN_CAP) { atomicAdd(&(bar)[XB_TMO], 1u); break; } } } } while (0)

struct XcdBarrier {
    unsigned* bar; unsigned x;
    volatile LAS unsigned* st;
};

__device__ __forceinline__ XcdBarrier xcd_barrier_post(unsigned* bar, volatile LAS unsigned* st) {
    XcdBarrier b; b.bar = bar; b.x = xb_xcc_id(); b.st = st;
    if (threadIdx.x == 0) (void)xb_add(&bar[XB_XCNT(b.x)], 1u);
    return b;
}
__device__ __forceinline__ void xcd_barrier_complete(unsigned* bar, unsigned x, unsigned& nloc, unsigned& nx) {
    const unsigned G = gridDim.x * gridDim.y * gridDim.z;
    unsigned sum, cnt, mine, sp = 0u;
    for (;;) {
        sum = 0u; cnt = 0u; mine = 0u;
#pragma unroll
        for (unsigned j = 0; j < 16; ++j) { const unsigned c = xb_ld(&bar[XB_XCNT(j)]); sum += c; cnt += (c > 0u) ? 1u : 0u; mine = (j == x) ? c : mine; }
        if (sum == G) break;
        __builtin_amdgcn_s_sleep(1);
        if ((++sp & 255u) == 0u) { if (xb_ld(&bar[XB_TMO])) break; if (sp > XB_SPIN_CAP) { atomicAdd(&bar[XB_TMO], 1u); break; } }
    }
    nloc = mine > 0u ? mine : 1u; nx = cnt > 0u ? cnt : 1u;
}

__device__ __forceinline__ void xcd_barrier(const XcdBarrier& b) {
    asm volatile("s_waitcnt vmcnt(0)" ::: "memory");
    __syncthreads();
    if (threadIdx.x == 0) {
        unsigned* bar = b.bar;
        __builtin_amdgcn_s_waitcnt(0);
        unsigned nloc = b.st[0], nx = b.st[1];
        if (nloc == 0u) { xcd_barrier_complete(bar, b.x, nloc, nx); b.st[0] = nloc; b.st[1] = nx; }
        const unsigned old = xb_add(&bar[XB_XSUB(b.x)], 1u);
        const unsigned gen = old / nloc;
        if (old + 1u == (gen + 1u) * nloc) {
            __builtin_amdgcn_fence(__ATOMIC_RELEASE, "agent");
            asm volatile("s_waitcnt vmcnt(0)" ::: "memory");
            const unsigned og = xb_add(&bar[XB_TOP], 1u);
            const unsigned tg = og / nx;
            if (og + 1u == (tg + 1u) * nx) xb_add(&bar[XB_TOPGEN], 1u);
            else XB_SPIN(xb_ld(&bar[XB_TOPGEN]) == tg, bar);
            __builtin_amdgcn_fence(__ATOMIC_ACQUIRE, "agent");
            xb_add(&bar[XB_XGEN(b.x)], 1u);
            asm volatile("s_waitcnt vmcnt(0)" ::: "memory");
        } else {
            XB_SPIN(xb_ld(&bar[XB_XGEN(b.x)]) == gen, bar);
            __builtin_amdgcn_fence(__ATOMIC_ACQUIRE, "agent");
            asm volatile("s_waitcnt vmcnt(0)" ::: "memory");
        }
    }
    __syncthreads();
}

__global__ void __launch_bounds__(512) fwd_megakernel(Args args) {
    extern __shared__ __attribute__((aligned(16))) unsigned char lds_raw[];
    cg::grid_group grid = cg::this_grid();
    const int wave_s = __builtin_amdgcn_readfirstlane((int)threadIdx.x >> 6);
    {
        LAS unsigned long long* tb = (LAS unsigned long long*)((LAS unsigned char*)lds_raw + ARG_OFF);
        if (threadIdx.x < 21) tb[threadIdx.x] = (unsigned long long)args.in[threadIdx.x];
        if (threadIdx.x == 21) tb[21] = (unsigned long long)args.out;
        if (threadIdx.x == 22) tb[22] = (unsigned long long)args.ws;
        if (threadIdx.x >= 32 && threadIdx.x < 40) ((LAS float*)(tb + 23))[threadIdx.x - 32] = args.invf[threadIdx.x - 32];
        if (threadIdx.x == 64) { ((LAS unsigned*)((LAS unsigned char*)lds_raw + ARG_OFF + 256))[0] = 0u; ((LAS unsigned*)((LAS unsigned char*)lds_raw + ARG_OFF + 256))[1] = 0u; }
        __syncthreads();
    }
    (void)xcd_barrier_post((unsigned*)(args.ws + WS_BAR), (volatile LAS unsigned*)((LAS unsigned char*)lds_raw + ARG_OFF + 256));
    int rep = 0;
    for (int ph = args.ph_lo; ph < args.ph_hi;) {
        int want = 1;
        const int tid_ = wave_s * 64 + lane_id_opaque();
        int bid_ = blockIdx.x, gsz_ = gridDim.x; asm volatile("" : "+s"(bid_), "+s"(gsz_));
        Ctx C; C.lds = (LAS unsigned char*)lds_raw; C.ws = nullptr; C.tid = tid_; C.lane = C.tid & 63; C.wave = wave_s;
        C.bid = bid_; C.gsz = gsz_;
        unsigned char* ws = (unsigned char*)argp(C.lds, 22); C.ws = ws;
        C.gw = C.bid * 8 + C.wave; C.ngw = C.gsz * 8;
        bf16_t* Z = (bf16_t*)(ws + WS_BIG); bf16_t* U = (bf16_t*)(ws + WS_BIG); bf16_t* PP = (bf16_t*)(ws + WS_PP);
        bf16_t* hbA = (bf16_t*)(ws + WS_HBA); bf16_t* hbB = (bf16_t*)(ws + WS_HBB);
        float* ssqA = (float*)(ws + WS_SSQA); float* ssqB = (float*)(ws + WS_SSQB); float* ssqC = (float*)(ws + WS_SSQC);
        float* lse = (float*)(ws + WS_LSE); float* rope = (float*)(ws + WS_ROPE);
        int njobs = 0, jtype = 0, L = 0;
        if (ph == 0) phase_prologue(C);
        else if (ph == NPHASE - 1) phase_final(C);
        else {
            L = (ph - 1) / 9; const int s = (ph - 1) % 9;
            if (s == 0) { phase_convert(C, L); want = 1 + PROBE_CVT; }
            else if (s == 1) { njobs = 1; jtype = 0; }
            else if (s == 2) { phase_attn(C, Z, lse, false); want = 1 + PROBE_ATTN; }
            else if (s == 3) { phase_mix(C, Z, lse, L, false); want = 1 + PROBE_MIX; }
            else if (s == 4) { njobs = 6; jtype = 1; }
            else if (s == 5) { njobs = 1; jtype = 2; }
            else if (s == 6) { njobs = 1; jtype = 3; }
            else if (s == 7) { njobs = 2; jtype = 4; }
            else { njobs = 1; jtype = 6; }
        }
        for (int ji = 0; ji < njobs; ++ji) {
            const int jt = jtype == 1 ? ((ji & 1) ? 1 : 0) : (jtype + ((jtype == 4) ? ji : 0));
            const bool gate_job = (jtype == 1);
            if (jt == 0) {
                const int b = ji >> 1;
                EpiIn E{gate_job ? (bf16_t*)(ws + WS_G) : Z, ssqC, rope, (bf16_t*)nullptr, gate_job ? DM : ZW, gate_job ? 4 : -1};
                want = gate_job ? 1 + PROBE_GATE : 1 + PROBE_IN + PROBE_INDRY;
                run_gemm(C.lds, C.bid, C.gsz, C.wave, hbB, DM, (const bf16_t*)(ws + WS_WIN) + (gate_job ? (size_t)(ZW + b * DM) * DM : 0), MTOK, gate_job ? DM : ZW, DM, E);
            } else if (jt == 1) {
                const int b = ji >> 1;
                const int ca = b == 0 ? CQ : (b == 1 ? CB : CU); const int kk = b == 0 ? 768 : 512;
                const bf16_t* bt = (const bf16_t*)(ws + (b == 0 ? WS_WBA : (b == 1 ? WS_WBB : WS_WBC)));
                EpiGate E{(const bf16_t*)(ws + WS_G), Z + CK, b > 0, (bf16_t*)nullptr}; want = 1 + PROBE_GATE; run_gemm(C.lds, C.bid, C.gsz, C.wave, Z + ca, ZW, bt, MTOK, DM, kk, E);
            } else if (jt == 2 || jt == 4) {
                const bool mix = (jt == 2);
                EpiRes E{mix ? hbB : hbA, hbA, mix ? ssqA : ssqB, (float*)nullptr};
                want = 1 + (mix ? PROBE_RESMIX : PROBE_DOWN);
                run_gemm(C.lds, C.bid, C.gsz, C.wave, mix ? Z + CK : U, mix ? ZW : UP, (const bf16_t*)(ws + (mix ? WS_WOUT3 : WS_WDOWN)), MTOK, DM, mix ? DM : DFF, E, mix ? DM : UP);
            } else if (jt == 3) { EpiUp E{U, ssqA}; want = 1 + PROBE_UP; run_gemm(C.lds, C.bid, C.gsz, C.wave, hbA, DM, (const bf16_t*)(ws + WS_WUP), MTOK, DFF, DM, E); }
            else if (jt == 5) { EpiPlain E{PP, DM}; run_gemm(C.lds, C.bid, C.gsz, C.wave, (const bf16_t*)(ws + WS_PBF), PLE, (const bf16_t*)(ws + WS_WPE), MTOK, DM, PLE, E); }
            else { EpiPle E{hbA, PP, ssqB, hbB, ssqC, (float*)nullptr}; want = 1 + PROBE_PLE; run_gemm(C.lds, C.bid, C.gsz, C.wave, hbA, DM, (const bf16_t*)(ws + WS_WPG), MTOK, DM, DM, E); }
        }
        if (++rep >= want) { rep = 0; ++ph; }
        if (ph < args.ph_hi) {
            if (ph == 1 && rep == 0) grid.sync();
            else {
                XcdBarrier xbar; xbar.bar = (unsigned*)(ws + WS_BAR); xbar.x = xb_xcc_id(); xbar.st = (volatile LAS unsigned*)(C.lds + ARG_OFF + 256);
                xcd_barrier(xbar); if (PROBE_SYNC) xcd_barrier(xbar);
            }
        }
    }
}

extern "C" void kernel_launch(void* const* d_in, const int* in_sizes, int n_in, void* d_out, int out_size, void* d_ws, size_t ws_size, hipStream_t stream) {
    static int grid = 0;
    if (grid == 0) {
        if (n_in != 21 || out_size != MTOK * DM || ws_size < WS_END) { fprintf(stderr, "kernel_launch: unexpected sizes (n_in %d out %d ws %zu)\n", n_in, out_size, ws_size); grid = -1; return; }
        int dev = 0, cus = 0, per_cu = 0;
        (void)hipGetDevice(&dev); (void)hipDeviceGetAttribute(&cus, hipDeviceAttributeMultiprocessorCount, dev);
        (void)hipFuncSetAttribute((const void*)fwd_megakernel, hipFuncAttributeMaxDynamicSharedMemorySize, LDS_BYTES);
        (void)hipOccupancyMaxActiveBlocksPerMultiprocessor(&per_cu, (const void*)fwd_megakernel, 512, LDS_BYTES);
        (void)hipGetLastError();
        if (per_cu < 1) per_cu = 1;
        grid = cus;
        if (grid <= 0) grid = 256;
    }
    if (grid < 0) return;
    (void)hipMemsetAsync((char*)d_ws + WS_BAR, 0, 16384, stream);
    Args a{};
    for (int i = 0; i < 21; ++i) a.in[i] = d_in[i];
    a.out = (float*)d_out; a.ws = (unsigned char*)d_ws;
    for (int j = 0; j < 8; ++j) a.invf[j] = (float)pow(500000.0, -(double)(2 * j) / 16.0);
#if MK_PER_PHASE_LAUNCH
    for (int ph = 0; ph < NPHASE; ++ph) { a.ph_lo = ph; a.ph_hi = ph + 1; hipLaunchKernelGGL(fwd_megakernel, dim3(grid), dim3(512), LDS_BYTES, stream, a); }
#else
    a.ph_lo = 0; a.ph_hi = NPHASE;
    void* kargs[] = {&a};
    hipError_t e = hipLaunchCooperativeKernel((const void*)fwd_megakernel, dim3(grid), dim3(512), kargs, LDS_BYTES, stream);
    if (e != hipSuccess) fprintf(stderr, "cooperative launch failed: %s (grid %d)\n", hipGetErrorString(e), grid);
#endif
}
```

```cpp
#include <hip/hip_runtime.h>
#include <hip/hip_cooperative_groups.h>
#include <cstdio>
#include <cstdint>
#include <cmath>
namespace cg = cooperative_groups;
#ifndef PROBE_ATTN
#define PROBE_ATTN 0
#endif
#ifndef PROBE_MIX
#define PROBE_MIX 0
#endif
#ifndef PROBE_CVT
#define PROBE_CVT 0
#endif
#ifndef PROBE_IN
#define PROBE_IN 0
#endif
#ifndef PROBE_UP
#define PROBE_UP 0
#endif
#ifndef PROBE_GATE
#define PROBE_GATE 0
#endif
#ifndef PROBE_RESMIX
#define PROBE_RESMIX 0
#endif
#ifndef PROBE_DOWN
#define PROBE_DOWN 0
#endif
#ifndef PROBE_PLE
#define PROBE_PLE 0
#endif
#ifndef PROBE_INDRY
#define PROBE_INDRY 0
#endif
#ifndef PROBE_SYNC
#define PROBE_SYNC 0
#endif
#ifndef MK_PER_PHASE_LAUNCH
#define MK_PER_PHASE_LAUNCH 0
#endif
__device__ __forceinline__ int lane_id_opaque();
namespace pg8 {
#define PG8_LAS __attribute__((address_space(3)))
typedef unsigned short bf16_t;
typedef short bf16x8 __attribute__((ext_vector_type(8)));
typedef float f32x4 __attribute__((ext_vector_type(4)));
typedef unsigned u32x4 __attribute__((ext_vector_type(4)));
constexpr int BM = 256, BK = 64, HALF = 128, HTB = HALF * BK * 2  , STAGE_BYTES = 8 * HTB, NXCD = 8, WGM = 4;

__host__ __device__ __forceinline__ int lds_byte(int r, int c) { const int st = (r >> 4) * 2 + (c >> 5), rr = r & 15, cc = c & 31, ob = rr * 64 + cc * 2; return st * 1024 + (ob ^ (((ob >> 9) & 1) << 5)); }
__host__ __device__ __forceinline__ void stage_rc(int b, int& R, int& C) { const int st = b / 1024, sb = b % 1024, swz = sb ^ (((sb >> 9) & 1) << 5); R = (st >> 1) * 16 + swz / 64; C = (st & 1) * 32 + (swz % 64) / 2; }
__host__ __device__ __forceinline__ int perm32(int rho) { const int n = rho >> 4, i = rho & 15; return 8 * (i >> 2) + 4 * n + (i & 3); }

struct Unit { int pm, pn; };
struct Gemm { const bf16_t* A; int lda; const bf16_t* Bt; int ldb; int M, N, K, wave; };

struct StaticOrder {
    int nM, nN, nwg, G, c;
    __host__ __device__ void init(int M, int N, int G_, int c_) { nM = M / BM; nN = N / BM; nwg = nM * nN; G = G_; c = c_; }
    __host__ __device__ bool next(int i, Unit& u) const {
        const long L = (long)i * G + c; if (L >= nwg) return false;
        int wgid = (int)L; { const int q = nwg / NXCD, r = nwg % NXCD, xcd = wgid % NXCD, off = wgid / NXCD; wgid = (xcd < r ? xcd * (q + 1) : r * (q + 1) + (xcd - r) * q) + off; }
        const int nig = WGM * nN, gid = wgid / nig, fm = gid * WGM, gsz = (nM - fm) < WGM ? (nM - fm) : WGM;
        u.pm = fm + ((wgid % nig) % gsz); u.pn = (wgid % nig) / gsz; return true;
    }
    __device__ __forceinline__ void a_ready(const Unit&) const {}
    __device__ __forceinline__ void done(const Unit&) const {}
};

__device__ __forceinline__ unsigned cvt_pk_bf16(float lo, float hi) { unsigned r; asm volatile("v_cvt_pk_bf16_f32 %0, %1, %2" : "=v"(r) : "v"(lo), "v"(hi)); return r; }
typedef float f32x2 __attribute__((ext_vector_type(2)));
__device__ __forceinline__ f32x2 gelu_pk(f32x2 v) {
    const f32x2 av = __builtin_elementwise_abs(v), d = av * 0.2316418882f + 1.0f;
    f32x2 t; t.x = __builtin_amdgcn_rcpf(d.x); t.y = __builtin_amdgcn_rcpf(d.y);
    f32x2 q = t * 0.5307027145f + (-0.7265760135f); q = q * t + 0.7107068705f; q = q * t + (-0.142248368f); q = q * t + 0.127414796f; q = q * t;
    const f32x2 s = (v * v) * (-0.72134752044f);
    f32x2 e; e.x = __builtin_amdgcn_exp2f(s.x); e.y = __builtin_amdgcn_exp2f(s.y);
    const f32x2 m = v * (q * e), r = v - m;
    f32x2 o; o.x = v.x < 0.f ? m.x : r.x; o.y = v.y < 0.f ? m.y : r.y; return o;
}
template <class Epi, class Sched, bool ALIGN_EPI = false, bool SP2 = false>
__device__ __forceinline__ void gemm_phase(PG8_LAS unsigned char* lds, const Gemm g, const Sched& S, const Epi& E) {
    const int tid = g.wave * 64 + lane_id_opaque(),
        wid = __builtin_amdgcn_readfirstlane(tid >> 6), lane = tid & 63, wr = wid >> 2, wc = wid & 3, fr = lane & 15, fq = lane >> 4;
    const int K = g.K, nt = K / BK;
    unsigned voffA[2], voffB[2];
#pragma unroll
    for (int i = 0; i < 2; ++i) { int R, C; stage_rc(tid * 16 + i * 8192, R, C); const int Rb = Epi::PERM ? ((R & ~31) + perm32(R & 31)) : R;
        voffA[i] = (unsigned)(R * g.lda + C) * 2u; voffB[i] = (unsigned)(Rb * g.ldb + C) * 2u; }
    const size_t kstep = (size_t)(BK * 2);
    const size_t hstepA = (size_t)HALF * g.lda * 2, hstepB = (size_t)HALF * g.ldb * 2;
    const size_t tstepA = 2 * hstepA, tstepB = 2 * hstepB;
    const unsigned ldsw = (unsigned)wid * 1024u;
    const int aoff = lds_byte(wr * 64 + fr, fq * 8), boff = lds_byte(wc * 32 + fr, fq * 8);
#define PG8_SA(b, h) (((b) * 2 + (h)) * HTB)
#define PG8_SB(b, h) ((4 + (b) * 2 + (h)) * HTB)
#define PG8_STAGE(bufoff, gbase, voff) do { _Pragma("unroll") for (int _i = 0; _i < 2; ++_i) \
        __builtin_amdgcn_global_load_lds((const unsigned*)((const char*)(gbase) + (voff)[_i]), (PG8_LAS unsigned*)(lds + (bufoff) + ldsw + _i * 8192), 16, 0, 0); } while (0)
#define PG8_LDA(dst, b, h) do { _Pragma("unroll") for (int m = 0; m < 4; ++m) _Pragma("unroll") for (int k = 0; k < 2; ++k) dst[m][k] = *(const PG8_LAS bf16x8*)(lds + PG8_SA(b, h) + aoff + m * 2048 + k * 1024); } while (0)
#define PG8_LDB(dst, b, h) do { _Pragma("unroll") for (int n = 0; n < 2; ++n) _Pragma("unroll") for (int k = 0; k < 2; ++k) dst[n][k] = *(const PG8_LAS bf16x8*)(lds + PG8_SB(b, h) + boff + n * 2048 + k * 1024); } while (0)
#define PG8_MMA(ai, bj, At, Bt) do { __builtin_amdgcn_s_setprio(1); _Pragma("unroll") for (int m = 0; m < 4; ++m) _Pragma("unroll") for (int n = 0; n < 2; ++n) _Pragma("unroll") for (int k = 0; k < 2; ++k) \
        acc[ai][bj][m][n] = __builtin_amdgcn_mfma_f32_16x16x32_bf16(Bt[n][k], At[m][k], acc[ai][bj][m][n], 0, 0, 0); __builtin_amdgcn_s_setprio(0); } while (0)
#define PG8_WAIT_V(n) asm volatile("s_waitcnt vmcnt(" #n ")" ::: "memory")
#define PG8_WAIT_L(n) asm volatile("s_waitcnt lgkmcnt(" #n ")" ::: "memory")
#define PG8_BAR __builtin_amdgcn_s_barrier()
#define PG8_SCHED __builtin_amdgcn_sched_barrier(0)
    Unit cur, nxt; int ui = 0;
    if (!S.next(0, cur)) return;
    f32x4 acc[2][2][4][2];
#pragma unroll
    for (int a = 0; a < 2; ++a)
#pragma unroll
        for (int b = 0; b < 2; ++b)
#pragma unroll
            for (int m = 0; m < 4; ++m)
#pragma unroll
                for (int n = 0; n < 2; ++n) acc[a][b][m][n] = (f32x4){0.f, 0.f, 0.f, 0.f};
    bf16x8 At[4][2], B0[2][2], B1[2][2];
    const char* cA = (const char*)g.A + (size_t)cur.pm * tstepA; const char* cB = (const char*)g.Bt + (size_t)cur.pn * tstepB;
    S.a_ready(cur);
    if constexpr (SP2) {
        PG8_STAGE(PG8_SB(0, 0), cB, voffB); PG8_STAGE(PG8_SB(0, 1), cB + hstepB, voffB); PG8_STAGE(PG8_SA(0, 0), cA, voffA); PG8_STAGE(PG8_SA(0, 1), cA + hstepA, voffA);
        if (wr == 1) PG8_BAR;
        PG8_WAIT_V(2); PG8_BAR;
        PG8_STAGE(PG8_SB(1, 0), cB + kstep, voffB); PG8_STAGE(PG8_SA(1, 0), cA + kstep, voffA); PG8_STAGE(PG8_SB(1, 1), cB + hstepB + kstep, voffB);
        PG8_WAIT_V(6); PG8_BAR;
    } else {
        PG8_STAGE(PG8_SB(0, 0), cB, voffB); PG8_STAGE(PG8_SA(0, 0), cA, voffA); PG8_STAGE(PG8_SB(0, 1), cB + hstepB, voffB); PG8_STAGE(PG8_SA(0, 1), cA + hstepA, voffA);
        if (wr == 1) PG8_BAR;
        PG8_WAIT_V(4); PG8_BAR;
        PG8_STAGE(PG8_SB(1, 0), cB + kstep, voffB); PG8_STAGE(PG8_SA(1, 0), cA + kstep, voffA); PG8_STAGE(PG8_SB(1, 1), cB + hstepB + kstep, voffB);
        PG8_WAIT_V(6); PG8_BAR;
    }
    for (;;) {
        const bool has_next = S.next(ui + 1, nxt);
        const char* nA = has_next ? (const char*)g.A + (size_t)nxt.pm * tstepA : cA; const char* nB = has_next ? (const char*)g.Bt + (size_t)nxt.pn * tstepB : cB;
        for (int t = 0; t < nt; t += 2) {
            const bool last = (t == nt - 2);
            const char* a1 = cA + (size_t)(t + 1) * kstep;
            const char* a2 = last ? nA : cA + (size_t)(t + 2) * kstep; const char* b2 = last ? nB : cB + (size_t)(t + 2) * kstep;
            const char* a3 = a2 + kstep; const char* b3 = b2 + kstep;
            if (last && has_next) S.a_ready(nxt);
            if constexpr (SP2) {
            PG8_LDB(B0, 0, 0); PG8_LDB(B1, 0, 1); PG8_SCHED; PG8_LDA(At, 0, 0); PG8_STAGE(PG8_SA(1, 1), a1 + hstepA, voffA);
            PG8_WAIT_V(8); PG8_WAIT_L(0); PG8_BAR; PG8_MMA(0, 0, At, B0); PG8_MMA(0, 1, At, B1); PG8_BAR; PG8_SCHED;
            PG8_LDA(At, 0, 1); PG8_STAGE(PG8_SB(0, 0), b2, voffB); PG8_STAGE(PG8_SB(0, 1), b2 + hstepB, voffB); PG8_STAGE(PG8_SA(0, 0), a2, voffA);
            PG8_WAIT_V(8); PG8_WAIT_L(0); PG8_BAR; PG8_MMA(1, 0, At, B0); PG8_MMA(1, 1, At, B1); PG8_BAR; PG8_SCHED;
            PG8_LDB(B0, 1, 0); PG8_LDB(B1, 1, 1); PG8_SCHED; PG8_LDA(At, 1, 0); PG8_STAGE(PG8_SA(0, 1), a2 + hstepA, voffA);
            PG8_WAIT_V(8); PG8_WAIT_L(0); PG8_BAR; PG8_MMA(0, 0, At, B0); PG8_MMA(0, 1, At, B1); PG8_BAR; PG8_SCHED;
            PG8_LDA(At, 1, 1); PG8_STAGE(PG8_SB(1, 0), b3, voffB); PG8_STAGE(PG8_SB(1, 1), b3 + hstepB, voffB); PG8_STAGE(PG8_SA(1, 0), a3, voffA);
            PG8_WAIT_V(8); PG8_WAIT_L(0); PG8_BAR; PG8_MMA(1, 0, At, B0); PG8_MMA(1, 1, At, B1); PG8_BAR; PG8_SCHED;
            } else {
            PG8_LDB(B0, 0, 0); PG8_SCHED; PG8_LDA(At, 0, 0); PG8_STAGE(PG8_SA(1, 1), a1 + hstepA, voffA);
            PG8_WAIT_L(8); PG8_BAR; PG8_WAIT_L(0); PG8_MMA(0, 0, At, B0); PG8_BAR; PG8_SCHED;
            PG8_LDB(B1, 0, 1); PG8_STAGE(PG8_SB(0, 0), b2, voffB);
            PG8_BAR; PG8_WAIT_L(0); PG8_MMA(0, 1, At, B1); PG8_BAR;
            PG8_LDA(At, 0, 1); PG8_STAGE(PG8_SA(0, 0), a2, voffA);
            PG8_BAR; PG8_WAIT_L(0); PG8_MMA(1, 0, At, B0); PG8_BAR; PG8_SCHED;
            PG8_STAGE(PG8_SB(0, 1), b2 + hstepB, voffB);
            PG8_WAIT_V(6); PG8_BAR; PG8_MMA(1, 1, At, B1); PG8_BAR;
            PG8_LDB(B0, 1, 0); PG8_SCHED; PG8_LDA(At, 1, 0); PG8_STAGE(PG8_SA(0, 1), a2 + hstepA, voffA);
            PG8_WAIT_L(8); PG8_BAR; PG8_WAIT_L(0); PG8_MMA(0, 0, At, B0); PG8_BAR; PG8_SCHED;
            PG8_LDB(B1, 1, 1); PG8_STAGE(PG8_SB(1, 0), b3, voffB);
            PG8_BAR; PG8_WAIT_L(0); PG8_MMA(0, 1, At, B1); PG8_BAR;
            PG8_LDA(At, 1, 1); PG8_STAGE(PG8_SA(1, 0), a3, voffA);
            PG8_BAR; PG8_WAIT_L(0); PG8_MMA(1, 0, At, B0); PG8_BAR; PG8_SCHED;
            PG8_STAGE(PG8_SB(1, 1), b3 + hstepB, voffB);
            PG8_WAIT_V(6); PG8_BAR; PG8_MMA(1, 1, At, B1); PG8_BAR;
            }
        }
        if constexpr (ALIGN_EPI) { if (wr == 0) PG8_BAR; }
        if constexpr (!Epi::AFTER_DRAIN) { E(acc, cur, wr, wc, fr, fq); S.done(cur); }
        if (!has_next) break;
#pragma unroll
        for (int a = 0; a < 2; ++a)
#pragma unroll
            for (int b = 0; b < 2; ++b)
#pragma unroll
                for (int m = 0; m < 4; ++m)
#pragma unroll
                    for (int n = 0; n < 2; ++n) acc[a][b][m][n] = (f32x4){0.f, 0.f, 0.f, 0.f};
        cur = nxt; cA = nA; cB = nB; ++ui;
        if constexpr (ALIGN_EPI) { if (wr == 1) PG8_BAR; }
    }
    PG8_WAIT_V(0);
    if constexpr (!ALIGN_EPI) { if (wr == 0) PG8_BAR; }
    PG8_BAR;
    if constexpr (Epi::AFTER_DRAIN) { E.fused(acc, cur, wr, wc, fr, fq, lds, wid, lane); S.done(cur); }
#undef PG8_SA
#undef PG8_SB
#undef PG8_STAGE
#undef PG8_LDA
#undef PG8_LDB
#undef PG8_MMA
#undef PG8_WAIT_V
#undef PG8_WAIT_L
#undef PG8_BAR
#undef PG8_SCHED
}
}

#define DI __device__ __forceinline__
#define LAS __attribute__((address_space(3)))
#define GAS __attribute__((address_space(1)))
typedef unsigned short bf16_t;
typedef float f32x4 __attribute__((ext_vector_type(4)));
typedef float f32x2 __attribute__((ext_vector_type(2)));
typedef unsigned u32x4 __attribute__((ext_vector_type(4)));
typedef unsigned u32x2 __attribute__((ext_vector_type(2)));
typedef short bf16x8 __attribute__((ext_vector_type(8)));
typedef short s16x4 __attribute__((ext_vector_type(4)));

constexpr int DM = 1024, SEQ = 4096, NLAYER = 4, MTOK = 32768, MH = 16384, INW = 7936, DFF = 4096, PLE = 256;
constexpr int UP = 4160;
constexpr int ZW = 4864;
constexpr int CQ = 0, CK = 768, CV = 1536, CX = 2304, CB = 2816, CC = 3328, CU = 3840, CVV = 4352, CG = 4864;
constexpr size_t MiB = 1u << 20;
constexpr size_t WS_ROPE = 0, WS_SSQA = 2 * MiB, WS_SSQB = 4 * MiB, WS_SSQC = 6 * MiB, WS_LSE = 8 * MiB, WS_DUMMY = 9 * MiB + 524288, WS_BAR = 9 * MiB + 655360, WS_SGW = 9 * MiB + 786432,
                 WS_WIN = 10 * MiB, WS_WBA = 26 * MiB, WS_WBB = 28 * MiB, WS_WBC = 29 * MiB, WS_WOUT3 = 30 * MiB, WS_WUP = 36 * MiB,
                 WS_WDOWN = 44 * MiB, WS_WPG = 53 * MiB, WS_WPE = 55 * MiB, WS_PBF = 56 * MiB, WS_HBA = 72 * MiB, WS_HBB = 136 * MiB,
                 WS_BIG = 200 * MiB, WS_PP = 460 * MiB, WS_G = 504 * MiB, WS_END = 568 * MiB;
constexpr int LDS_BYTES = 147456;
constexpr int NPHASE = 2 + NLAYER * 9;

struct Args { const void* in[21]; float* out; unsigned char* ws; float invf[8]; int ph_lo, ph_hi; };

using pg8::cvt_pk_bf16;
DI float bf_lo(unsigned w) { return __uint_as_float(w << 16); }
DI float bf_hi(unsigned w) { return __uint_as_float(w & 0xffff0000u); }
DI int lane_id_opaque() { int l; asm volatile("v_mbcnt_lo_u32_b32 %0, -1, 0\n\tv_mbcnt_hi_u32_b32 %0, -1, %0" : "=v"(l)); return l; }
template <int X> DI float lane_xor(float v) {
    return __int_as_float(__builtin_amdgcn_ds_swizzle(__float_as_int(v), (X << 10) | 0x1f));
}
DI float sum_xor32(float v) { auto rr = __builtin_amdgcn_permlane32_swap(__float_as_uint(v), __float_as_uint(v), false, false); return __uint_as_float(rr[0]) + __uint_as_float(rr[1]); }
DI float max_xor32(float v) { auto rr = __builtin_amdgcn_permlane32_swap(__float_as_uint(v), __float_as_uint(v), false, false); return fmaxf(__uint_as_float(rr[0]), __uint_as_float(rr[1])); }
DI float wave_sum(float v) {
    v += lane_xor<1>(v); v += lane_xor<2>(v); v += lane_xor<4>(v); v += lane_xor<8>(v); v += lane_xor<16>(v);
    return sum_xor32(v);
}
DI float sigmoidf_fast(float x) { return __builtin_amdgcn_rcpf(1.0f + __builtin_amdgcn_exp2f(-1.4426950408889634f * x)); }
DI float row_rstd(const float* ssq, int row, int fq) {
    const f32x4 v = *(const GAS f32x4*)(ssq + (size_t)row * 16 + 4 * fq);
    float s = (v.x + v.y) + (v.z + v.w);
    s += lane_xor<16>(s); s = sum_xor32(s);
    return 1.0f / sqrtf(s * (1.0f / 1024.0f) + 1e-6f);
}

typedef const f32x4 (&AccRef)[2][2][4][2];
#define EPI_ROWS_BEGIN _Pragma("unroll") for (int ai = 0; ai < 2; ++ai) _Pragma("unroll") for (int m = 0; m < 4; ++m) { const int lrow = u.pm * 256 + ai * 128 + wr * 64 + m * 16 + fr;
#define EPI_COLS_BEGIN _Pragma("unroll") for (int bj = 0; bj < 2; ++bj) { const int col = u.pn * 256 + bj * 128 + wc * 32 + 8 * fq; f32x4 v0 = acc[ai][bj][m][0], v1 = acc[ai][bj][m][1];
#define EPI_END }
#define EPI_ROW_END }
#define EPI_PRELOAD_RSTD(ssqptr) float rs8[8]; { f32x4 q8_[8]; \
    _Pragma("unroll") for (int ai = 0; ai < 2; ++ai) _Pragma("unroll") for (int m = 0; m < 4; ++m) q8_[ai * 4 + m] = *(const GAS f32x4*)((ssqptr) + (size_t)(u.pm * 256 + ai * 128 + wr * 64 + m * 16 + fr) * 16 + 4 * fq); \
    asm volatile("" ::: "memory");     \
    _Pragma("unroll") for (int i_ = 0; i_ < 8; ++i_) { float s_ = (q8_[i_].x + q8_[i_].y) + (q8_[i_].z + q8_[i_].w); s_ += lane_xor<16>(s_); s_ = sum_xor32(s_); rs8[i_] = 1.0f / sqrtf(s_ * (1.0f / 1024.0f) + 1e-6f); } } \
    asm volatile("" ::: "memory");

struct EpiIn {
    static constexpr bool PERM = true, AFTER_DRAIN = false;
    bf16_t* Z; const float* ssq; const float* rope; bf16_t* dummy; int ldz, kind_force;
    DI void operator()(AccRef acc, const pg8::Unit& u, int wr, int wc, int, int) const {
        const int lane_ = lane_id_opaque(), fr = lane_ & 15, fq = lane_ >> 4;
        const int pn = u.pn;
        const int kind = dummy ? 2 : (kind_force >= 0 ? kind_force : (pn < 6 ? (pn < 3 ? 0 : 1) : (pn < 15 ? 2 : (pn < 19 ? 3 : 4))));
        const bool rot = (kind < 2) && ((wc & 1) == 0);
        const float qs = (kind == 0) ? 0.125f : 1.0f;
        EPI_PRELOAD_RSTD(ssq)
#pragma unroll
        for (int ai = 0; ai < 2; ++ai) {
        f32x4 rc0[4], rc1[4], rs0[4], rs1[4];
#pragma unroll
        for (int m = 0; m < 4; ++m) { rc0[m] = (f32x4){1.f, 1.f, 1.f, 1.f}; rc1[m] = rc0[m]; rs0[m] = (f32x4){0.f, 0.f, 0.f, 0.f}; rs1[m] = rs0[m]; }
        if (rot) {
#pragma unroll
            for (int m = 0; m < 4; ++m) { const GAS f32x4* rp = (const GAS f32x4*)(rope + (size_t)(u.pm * 256 + ai * 128 + wr * 64 + m * 16 + fr) * 16); rc0[m] = rp[0]; rc1[m] = rp[1]; rs0[m] = rp[2]; rs1[m] = rp[3]; }
        }
        asm volatile("" ::: "memory");
#pragma unroll
        for (int m = 0; m < 4; ++m) { const int lrow = u.pm * 256 + ai * 128 + wr * 64 + m * 16 + fr;
            const float rs = rs8[ai * 4 + m];
            const f32x4 c0 = rc0[m], c1 = rc1[m], s0 = rs0[m], s1 = rs1[m];
            EPI_COLS_BEGIN
                { const float rsk = (kind == 4) ? rs * -1.4426950408889634f : rs; v0 = v0 * rsk; v1 = v1 * rsk; }
                if (kind < 2) {
                    if (rot) {
                        f32x4 p0, p1;
#pragma unroll
                        for (int e = 0; e < 4; ++e) { p0[e] = lane_xor<16>(v0[e]); p1[e] = lane_xor<16>(v1[e]); }
                        if (fq == 0) { v0 = v0 * c0 - p0 * s0; v1 = v1 * c1 - p1 * s1; }
                        else if (fq == 1) { v0 = v0 * c0 + p0 * s0; v1 = v1 * c1 + p1 * s1; }
                    }
                    v0 = v0 * qs; v1 = v1 * qs;
                } else if (kind == 3) {
                    f32x2 a = pg8::gelu_pk((f32x2){v0[0], v0[1]}), b = pg8::gelu_pk((f32x2){v0[2], v0[3]}), c = pg8::gelu_pk((f32x2){v1[0], v1[1]}), d = pg8::gelu_pk((f32x2){v1[2], v1[3]});
                    v0 = (f32x4){a.x, a.y, b.x, b.y}; v1 = (f32x4){c.x, c.y, d.x, d.y};
                } else if (kind == 4) {
#pragma unroll
                    for (int e = 0; e < 4; ++e) { v0[e] = __builtin_amdgcn_rcpf(1.0f + __builtin_amdgcn_exp2f(v0[e])); v1[e] = __builtin_amdgcn_rcpf(1.0f + __builtin_amdgcn_exp2f(v1[e])); }
                }
                u32x4 w; w.x = cvt_pk_bf16(v0[0], v0[1]); w.y = cvt_pk_bf16(v0[2], v0[3]); w.z = cvt_pk_bf16(v1[0], v1[1]); w.w = cvt_pk_bf16(v1[2], v1[3]);
                *(GAS u32x4*)(dummy ? dummy + lane_ * 8 : Z + (size_t)lrow * ldz + col) = w;
            EPI_END
        }
        }
    }
};
struct EpiGate {
    static constexpr bool PERM = true, AFTER_DRAIN = false, HAS_LOADS = true;
    const bf16_t* G; bf16_t* Mo; int has_prev; bf16_t* dummy;
    DI void operator()(AccRef acc, const pg8::Unit& u, int wr, int wc, int, int) const {
        const int lane_ = lane_id_opaque(), fr = lane_ & 15, fq = lane_ >> 4;
#pragma unroll
        for (int ai = 0; ai < 2; ++ai) {
            u32x4 gq[4][2], pq[4][2];
#pragma unroll
            for (int m = 0; m < 4; ++m)
#pragma unroll
                for (int bj = 0; bj < 2; ++bj) {
                    const int lrow = u.pm * 256 + ai * 128 + wr * 64 + m * 16 + fr, col = u.pn * 256 + bj * 128 + wc * 32 + 8 * fq;
                    gq[m][bj] = *(const GAS u32x4*)(G + (size_t)lrow * DM + col);
                    pq[m][bj] = (u32x4){0u, 0u, 0u, 0u};
                    if (has_prev) pq[m][bj] = *(const GAS u32x4*)(Mo + (size_t)lrow * ZW + col);
                }
            asm volatile("" ::: "memory");
#pragma unroll
            for (int m = 0; m < 4; ++m) {
                const int lrow = u.pm * 256 + ai * 128 + wr * 64 + m * 16 + fr;
                EPI_COLS_BEGIN
                    const size_t off = (size_t)lrow * ZW + col;
                    const u32x4 g = gq[m][bj], p = pq[m][bj];
                    v0[0] = v0[0] * bf_lo(g.x) + bf_lo(p.x); v0[1] = v0[1] * bf_hi(g.x) + bf_hi(p.x); v0[2] = v0[2] * bf_lo(g.y) + bf_lo(p.y); v0[3] = v0[3] * bf_hi(g.y) + bf_hi(p.y);
                    v1[0] = v1[0] * bf_lo(g.z) + bf_lo(p.z); v1[1] = v1[1] * bf_hi(g.z) + bf_hi(p.z); v1[2] = v1[2] * bf_lo(g.w) + bf_lo(p.w); v1[3] = v1[3] * bf_hi(g.w) + bf_hi(p.w);
                    u32x4 w; w.x = cvt_pk_bf16(v0[0], v0[1]); w.y = cvt_pk_bf16(v0[2], v0[3]); w.z = cvt_pk_bf16(v1[0], v1[1]); w.w = cvt_pk_bf16(v1[2], v1[3]);
                    *(GAS u32x4*)(dummy ? dummy + lane_ * 8 : Mo + off) = w;
                EPI_END
            }
        }
    }
};
struct EpiRes {
    static constexpr bool PERM = true, AFTER_DRAIN = false, HAS_LOADS = true;
    const bf16_t* Hin; bf16_t* Hout; float* ssq_out; float* dummy;
    DI void operator()(AccRef acc, const pg8::Unit& u, int wr, int wc, int, int) const {
        const int lane_ = lane_id_opaque(), fr = lane_ & 15, fq = lane_ >> 4;
        u32x4 hv[2][4][2];
#pragma unroll
        for (int ai = 0; ai < 2; ++ai)
#pragma unroll
            for (int m = 0; m < 4; ++m)
#pragma unroll
                for (int bj = 0; bj < 2; ++bj)
                    hv[ai][m][bj] = *(const GAS u32x4*)(Hin + (size_t)(u.pm * 256 + ai * 128 + wr * 64 + m * 16 + fr) * DM + u.pn * 256 + bj * 128 + wc * 32 + 8 * fq);
        asm volatile("" ::: "memory");
        EPI_ROWS_BEGIN
            float ss = 0.f;
            EPI_COLS_BEGIN
                const size_t off = (size_t)lrow * DM + col;
                const u32x4 h4 = hv[ai][m][bj];
                v0[0] += bf_lo(h4.x); v0[1] += bf_hi(h4.x); v0[2] += bf_lo(h4.y); v0[3] += bf_hi(h4.y);
                v1[0] += bf_lo(h4.z); v1[1] += bf_hi(h4.z); v1[2] += bf_lo(h4.w); v1[3] += bf_hi(h4.w);
                ss += (v0[0] * v0[0] + v0[1] * v0[1]) + (v0[2] * v0[2] + v0[3] * v0[3]) + (v1[0] * v1[0] + v1[1] * v1[1]) + (v1[2] * v1[2] + v1[3] * v1[3]);
                u32x4 w; w.x = cvt_pk_bf16(v0[0], v0[1]); w.y = cvt_pk_bf16(v0[2], v0[3]); w.z = cvt_pk_bf16(v1[0], v1[1]); w.w = cvt_pk_bf16(v1[2], v1[3]);
                *(GAS u32x4*)(dummy ? (bf16_t*)(dummy + 2048) + lane_ * 8 : Hout + off) = w;
            EPI_END
            ss += lane_xor<16>(ss); ss = sum_xor32(ss);
            if (fq == 0) *(GAS float*)(dummy ? dummy + 4096 + lane_ : ssq_out + (size_t)lrow * 16 + u.pn * 4 + wc) = ss;
        EPI_ROW_END
    }
};
struct EpiUp {
    static constexpr bool PERM = true, AFTER_DRAIN = false;
    bf16_t* U; const float* ssq;
    DI void operator()(AccRef acc, const pg8::Unit& u, int wr, int wc, int, int) const {
        const int lane_ = lane_id_opaque(), fr = lane_ & 15, fq = lane_ >> 4;
        EPI_PRELOAD_RSTD(ssq)
        EPI_ROWS_BEGIN
            const float rs = rs8[ai * 4 + m];
            EPI_COLS_BEGIN
                {
                    const f32x4 z4 = {0.f, 0.f, 0.f, 0.f}; const float rs2 = rs * rs;
                    const f32x4 m0 = __builtin_elementwise_max(v0, z4), m1 = __builtin_elementwise_max(v1, z4);
                    v0 = (v0 * m0) * rs2; v1 = (v1 * m1) * rs2;
                }
                u32x4 w; w.x = cvt_pk_bf16(v0[0], v0[1]); w.y = cvt_pk_bf16(v0[2], v0[3]); w.z = cvt_pk_bf16(v1[0], v1[1]); w.w = cvt_pk_bf16(v1[2], v1[3]);
                *(GAS u32x4*)(U + (size_t)lrow * UP + col) = w;
            EPI_END
        EPI_ROW_END
    }
};
struct EpiPlain {
    static constexpr bool PERM = true, AFTER_DRAIN = false;
    bf16_t* O; int ldc;
    DI void operator()(AccRef acc, const pg8::Unit& u, int wr, int wc, int, int) const {
        const int lane_ = lane_id_opaque(), fr = lane_ & 15, fq = lane_ >> 4;
        EPI_ROWS_BEGIN
            EPI_COLS_BEGIN
                u32x4 w; w.x = cvt_pk_bf16(v0[0], v0[1]); w.y = cvt_pk_bf16(v0[2], v0[3]); w.z = cvt_pk_bf16(v1[0], v1[1]); w.w = cvt_pk_bf16(v1[2], v1[3]);
                *(GAS u32x4*)(O + (size_t)lrow * ldc + col) = w;
            EPI_END
        EPI_ROW_END
    }
};
struct EpiPle {
    static constexpr bool PERM = true, AFTER_DRAIN = false, HAS_LOADS = true;
    const bf16_t* Hin; const bf16_t* PP; const float* ssq; bf16_t* Hout; float* ssq_out; float* dummy;
    DI void operator()(AccRef acc, const pg8::Unit& u, int wr, int wc, int, int) const {
        const int lane_ = lane_id_opaque(), fr = lane_ & 15, fq = lane_ >> 4;
        EPI_PRELOAD_RSTD(ssq)
#pragma unroll
        for (int ai = 0; ai < 2; ++ai) {
            u32x4 hq[4][2];
#pragma unroll
            for (int m = 0; m < 4; ++m)
#pragma unroll
                for (int bj = 0; bj < 2; ++bj)
                    hq[m][bj] = *(const GAS u32x4*)(Hin + (size_t)(u.pm * 256 + ai * 128 + wr * 64 + m * 16 + fr) * DM + u.pn * 256 + bj * 128 + wc * 32 + 8 * fq);
            asm volatile("" ::: "memory");
#pragma unroll
            for (int mp = 0; mp < 2; ++mp) {
                u32x4 gq[2][2];
#pragma unroll
                for (int mm = 0; mm < 2; ++mm)
#pragma unroll
                    for (int bj = 0; bj < 2; ++bj)
                        gq[mm][bj] = *(const GAS u32x4*)(PP + (size_t)(u.pm * 256 + ai * 128 + wr * 64 + (2 * mp + mm) * 16 + fr) * DM + u.pn * 256 + bj * 128 + wc * 32 + 8 * fq);
                asm volatile("" ::: "memory");
#pragma unroll
                for (int mm = 0; mm < 2; ++mm) {
                    const int m = 2 * mp + mm;
                    const int lrow = u.pm * 256 + ai * 128 + wr * 64 + m * 16 + fr;
                    const float rs = rs8[ai * 4 + m];
                    float ss = 0.f;
                    EPI_COLS_BEGIN
                        const size_t off = (size_t)lrow * DM + col;
                        const u32x4 g = gq[mm][bj], hv = hq[m][bj];
                        v0[0] = bf_lo(hv.x) + sigmoidf_fast(v0[0] * rs) * bf_lo(g.x); v0[1] = bf_hi(hv.x) + sigmoidf_fast(v0[1] * rs) * bf_hi(g.x);
                        v0[2] = bf_lo(hv.y) + sigmoidf_fast(v0[2] * rs) * bf_lo(g.y); v0[3] = bf_hi(hv.y) + sigmoidf_fast(v0[3] * rs) * bf_hi(g.y);
                        v1[0] = bf_lo(hv.z) + sigmoidf_fast(v1[0] * rs) * bf_lo(g.z); v1[1] = bf_hi(hv.z) + sigmoidf_fast(v1[1] * rs) * bf_hi(g.z);
                        v1[2] = bf_lo(hv.w) + sigmoidf_fast(v1[2] * rs) * bf_lo(g.w); v1[3] = bf_hi(hv.w) + sigmoidf_fast(v1[3] * rs) * bf_hi(g.w);
                        ss += (v0[0] * v0[0] + v0[1] * v0[1]) + (v0[2] * v0[2] + v0[3] * v0[3]) + (v1[0] * v1[0] + v1[1] * v1[1]) + (v1[2] * v1[2] + v1[3] * v1[3]);
                        u32x4 w; w.x = cvt_pk_bf16(v0[0], v0[1]); w.y = cvt_pk_bf16(v0[2], v0[3]); w.z = cvt_pk_bf16(v1[0], v1[1]); w.w = cvt_pk_bf16(v1[2], v1[3]);
                        *(GAS u32x4*)(dummy ? (bf16_t*)(dummy + 2048) + lane_ * 8 : Hout + off) = w;
                    EPI_END
                    ss += lane_xor<16>(ss); ss = sum_xor32(ss);
                    if (fq == 0) *(GAS float*)(dummy ? dummy + 4096 + lane_ : ssq_out + (size_t)lrow * 16 + u.pn * 4 + wc) = ss;
                }
            }
        }
    }
};

template <class Epi>
DI void run_gemm(LAS unsigned char* lds, int bid, int gsz, int wave, const bf16_t* A, int lda, const bf16_t* Bt, int M, int N, int K, const Epi& E, int ldb = 0) {
    if (ldb == 0) ldb = K;
    pg8::Gemm g{A, lda, Bt, ldb, M, N, K, wave};
    pg8::StaticOrder S; S.init(M, N, gsz, bid);
    pg8::gemm_phase<Epi, pg8::StaticOrder, true, true>(lds, g, S, E);
}

DI void transpose_item(const float* W_, int K, int N, bf16_t* WT, int ldk, int koff, const float* gk_, LAS float* scr, int item, int lane) {
    const GAS float* W = (const GAS float*)W_; const GAS float* gk = (const GAS float*)gk_;
    const int nblk = N / 32, kb = item / nblk, nb = item % nblk, k0 = 64 * kb, n0 = 32 * nb;
    float wv_[32];
#pragma unroll
    for (int i = 0; i < 32; ++i) wv_[i] = __builtin_nontemporal_load(W + (size_t)(k0 + 2 * i + (lane >> 5)) * N + n0 + (lane & 31));
#pragma unroll
    for (int i = 0; i < 32; ++i) { const int kk = 2 * i + (lane >> 5); float v = wv_[i]; if (gk) v *= gk[k0 + kk]; scr[kk * 33 + (lane & 31)] = v; }
    asm volatile("s_waitcnt lgkmcnt(0)" ::: "memory");
    const int c = lane & 7;
#pragma unroll
    for (int j = 0; j < 4; ++j) { const int n = (lane >> 3) + 8 * j; const LAS float* s = scr + (8 * c) * 33 + n;
        u32x4 o; o.x = cvt_pk_bf16(s[0 * 33], s[1 * 33]); o.y = cvt_pk_bf16(s[2 * 33], s[3 * 33]); o.z = cvt_pk_bf16(s[4 * 33], s[5 * 33]); o.w = cvt_pk_bf16(s[6 * 33], s[7 * 33]);
        *(GAS u32x4*)(WT + (size_t)(n0 + n) * ldk + koff + k0 + 8 * c) = o; }
    asm volatile("s_waitcnt lgkmcnt(0)" ::: "memory");
}

constexpr int ARG_OFF = 131072;
DI const void* argp(LAS unsigned char* lds, int k) {
    unsigned a_ = ARG_OFF; asm volatile("" : "+s"(a_));
    const unsigned long long v = ((const LAS unsigned long long*)(lds + a_))[k];
    const unsigned lo = __builtin_amdgcn_readfirstlane((unsigned)v), hi = __builtin_amdgcn_readfirstlane((unsigned)(v >> 32));
    return (const void*)(((unsigned long long)hi << 32) | lo);
}
struct Ctx {
    LAS unsigned char* lds; unsigned char* ws; int tid, lane, wave, gw, ngw, bid, gsz;
};

DI void phase_prologue(const Ctx& C) {
    const GAS float* x = (const GAS float*)argp(C.lds, 0); const GAS int* pos = (const GAS int*)argp(C.lds, 2);
    GAS bf16_t* hbB = (GAS bf16_t*)(C.ws + WS_HBB); GAS float* ssqC = (GAS float*)(C.ws + WS_SSQC); GAS float* rope = (GAS float*)(C.ws + WS_ROPE);
    for (int m0 = C.gw; m0 < MTOK; m0 += 8 * C.ngw) {
        f32x4 v[8][4];
#pragma unroll
        for (int k = 0; k < 8; ++k) { const int m = m0 + k * C.ngw; if (m < MTOK) { const GAS f32x4* xr = (const GAS f32x4*)(x + (size_t)m * DM) + C.lane;
#pragma unroll
            for (int j = 0; j < 4; ++j) v[k][j] = __builtin_nontemporal_load(xr + 64 * j); } }
#pragma unroll
        for (int k = 0; k < 8; ++k) { const int m = m0 + k * C.ngw; if (m < MTOK) {
            GAS u32x2* br = (GAS u32x2*)(hbB + (size_t)m * DM) + C.lane; float s = 0.f;
#pragma unroll
            for (int j = 0; j < 4; ++j) { const f32x4 t = v[k][j]; s += (t.x * t.x + t.y * t.y) + (t.z * t.z + t.w * t.w);
                u32x2 w; w.x = cvt_pk_bf16(t.x, t.y); w.y = cvt_pk_bf16(t.z, t.w); br[64 * j] = w; }
            s = wave_sum(s);
            if (C.lane < 16) ssqC[(size_t)m * 16 + C.lane] = (C.lane == 0) ? s : 0.f; } }
    }
    const int gt = C.gw * 64 + C.lane, ngt = C.ngw * 64;
    for (int tok = gt; tok < MTOK; tok += ngt) {
        const float pf = (float)pos[tok];
#pragma unroll
        for (int j = 0; j < 8; ++j) {
            const float ang = __fmul_rn(pf, ((const LAS float*)(C.lds + ARG_OFF + 23 * 8))[j]);
            const double rev = (double)ang * 0.15915494309189535; const float frc = (float)(rev - __builtin_rint(rev));
            rope[(size_t)tok * 16 + j] = __builtin_amdgcn_cosf(frc); rope[(size_t)tok * 16 + 8 + j] = __builtin_amdgcn_sinf(frc);
        }
    }
}

DI void phase_convert(const Ctx& C, int L) {
    LAS float* scr = (LAS float*)(C.lds + C.wave * 16384);
    const float* w_in = (const float*)argp(C.lds, 4) + (size_t)L * DM * INW; const float* g_mix = (const float*)argp(C.lds, 3) + L * DM;
    const float* w_ba = (const float*)argp(C.lds, 10) + (size_t)L * 768 * DM; const float* w_bb = (const float*)argp(C.lds, 11) + (size_t)L * 512 * DM; const float* w_bc = (const float*)argp(C.lds, 12) + (size_t)L * 512 * DM;
    const float* w_out = (const float*)argp(C.lds, 13) + (size_t)L * DM * DM;
    const float* w_up = (const float*)argp(C.lds, 15) + (size_t)L * DM * DFF; const float* g_mlp = (const float*)argp(C.lds, 14) + L * DM;
    const float* w_down = (const float*)argp(C.lds, 16) + (size_t)L * DFF * DM;
    const float* w_pg = (const float*)argp(C.lds, 18) + (size_t)L * DM * DM; const float* g_ple = (const float*)argp(C.lds, 17) + L * DM;
    const float* w_pe = (const float*)argp(C.lds, 19) + (size_t)L * PLE * DM;
    constexpr int I_IN = 16 * (INW / 32), I_BA = 12 * 32, I_BB = 8 * 32, I_OUT = 16 * 32, I_UP = 16 * (DFF / 32), I_DOWN = 64 * 32, I_PG = 16 * 32, I_PE = 4 * 32;
    constexpr int NITEMS = I_IN + I_BA + 2 * I_BB + I_OUT + I_UP + I_DOWN + I_PG + I_PE;
    for (int it = C.gw; it < NITEMS; it += C.ngw) {
        int r = it;
        if (r < I_IN) { transpose_item(w_in, DM, INW, (bf16_t*)(C.ws + WS_WIN), DM, 0, g_mix, scr, r, C.lane); continue; } r -= I_IN;
        if (r < I_BA) { transpose_item(w_ba, 768, DM, (bf16_t*)(C.ws + WS_WBA), 768, 0, nullptr, scr, r, C.lane); continue; } r -= I_BA;
        if (r < I_BB) { transpose_item(w_bb, 512, DM, (bf16_t*)(C.ws + WS_WBB), 512, 0, nullptr, scr, r, C.lane); continue; } r -= I_BB;
        if (r < I_BB) { transpose_item(w_bc, 512, DM, (bf16_t*)(C.ws + WS_WBC), 512, 0, nullptr, scr, r, C.lane); continue; } r -= I_BB;
        if (r < I_OUT) { transpose_item(w_out, DM, DM, (bf16_t*)(C.ws + WS_WOUT3), DM, 0, nullptr, scr, r, C.lane); continue; } r -= I_OUT;
        if (r < I_UP) { transpose_item(w_up, DM, DFF, (bf16_t*)(C.ws + WS_WUP), DM, 0, g_mlp, scr, r, C.lane); continue; } r -= I_UP;
        if (r < I_DOWN) { transpose_item(w_down, DFF, DM, (bf16_t*)(C.ws + WS_WDOWN), UP, 0, nullptr, scr, r, C.lane); continue; } r -= I_DOWN;
        if (r < I_PG) { transpose_item(w_pg, DM, DM, (bf16_t*)(C.ws + WS_WPG), DM, 0, g_ple, scr, r, C.lane); continue; } r -= I_PG;
        transpose_item(w_pe, PLE, DM, (bf16_t*)(C.ws + WS_WPE), PLE, 0, nullptr, scr, r, C.lane);
    }
    const int gt = C.gw * 64 + C.lane, ngt = C.ngw * 64;
    const float* p = (const float*)argp(C.lds, 1) + (size_t)L * MTOK * PLE; bf16_t* pbf = (bf16_t*)(C.ws + WS_PBF);
    for (int i = gt; i < MTOK * PLE / 8; i += ngt) {
        const f32x4 a = *(const GAS f32x4*)(p + (size_t)i * 8), b = *(const GAS f32x4*)(p + (size_t)i * 8 + 4);
        u32x4 w; w.x = cvt_pk_bf16(a.x, a.y); w.y = cvt_pk_bf16(a.z, a.w); w.z = cvt_pk_bf16(b.x, b.y); w.w = cvt_pk_bf16(b.z, b.w);
        *(GAS u32x4*)(pbf + (size_t)i * 8) = w;
    }
    const GAS float* sgw = (const GAS float*)argp(C.lds, 8) + (size_t)L * 4 * 128 * 128; bf16_t* sgb = (bf16_t*)(C.ws + WS_SGW);
    for (int i = gt; i < 4 * 128 * 128 / 2; i += ngt) {
        const int e = i * 2, s = e & 127, t = (e >> 7) & 127;
        const float a = (s <= t) ? sgw[e] : 0.f, b = (s + 1 <= t) ? sgw[e + 1] : 0.f;
        *(GAS unsigned*)(sgb + e) = cvt_pk_bf16(a, b);
    }
}

DI void phase_attn(const Ctx& C, bf16_t* Z, float* lse, bool dry) {
    const int tid = C.tid, lane = C.lane, w = C.wave, fr = lane & 15, fq = lane >> 4;
    LAS bf16_t* Ks = (LAS bf16_t*)C.lds;
    LAS bf16_t* Vt = (LAS bf16_t*)(C.lds + 36864);
    const int upc = 3072 / C.gsz, urem = 3072 - upc * C.gsz, nmine = upc + (C.bid < urem ? 1 : 0);
    int cslot = 1;
    for (int ui = 0; ui < nmine; ++ui) {
        const int uid = ui < upc ? C.bid * upc + ui : C.gsz * upc + C.bid;
        const int j = uid & 31, head = (uid >> 5) % 12, bl = uid / 384;
        const int g = head >> 2, dsh = 2 * g, nsh = 5 - dsh;
        const int r = j >> nsh, n = j & ((1 << nsh) - 1);
        const size_t rowb = (size_t)bl * SEQ + r;
        const bool reuse = (ui > 0) && (ui < upc) && (n > 0);
        cslot = reuse ? (cslot ^ 1) : 1;
        const int rot = 128 * (1 - cslot), rot16 = rot >> 4;
#pragma unroll
        for (int cc = 0; cc < 4; ++cc) {
            if (cc < 2 && reuse) continue;
            const int c = tid + cc * 512, kj = c >> 3, ch = c & 7, mm = (n - 1) * 128 + kj, pk = (kj + rot) & 255;
            u32x4 kv = {0u, 0u, 0u, 0u}, vv = {0u, 0u, 0u, 0u};
            if (mm >= 0) { const bf16_t* p = Z + (rowb + ((size_t)mm << dsh)) * ZW + head * 64 + ch * 8; kv = __builtin_nontemporal_load((const GAS u32x4*)(p + CK)); vv = __builtin_nontemporal_load((const GAS u32x4*)(p + CV)); }
            *(LAS u32x4*)(Ks + pk * 72 + ch * 8) = kv;
            LAS bf16_t* vp = Vt + (ch * 8) * 264 + (pk ^ (ch << 3));
            vp[0 * 264] = (bf16_t)(vv.x & 0xffffu); vp[1 * 264] = (bf16_t)(vv.x >> 16);
            vp[2 * 264] = (bf16_t)(vv.y & 0xffffu); vp[3 * 264] = (bf16_t)(vv.y >> 16);
            vp[4 * 264] = (bf16_t)(vv.z & 0xffffu); vp[5 * 264] = (bf16_t)(vv.z >> 16);
            vp[6 * 264] = (bf16_t)(vv.w & 0xffffu); vp[7 * 264] = (bf16_t)(vv.w >> 16);
        }
        const int qi = 16 * w + fr; const size_t qrow = rowb + ((size_t)(n * 128 + qi) << dsh);
        bf16_t* qp = Z + qrow * ZW + head * 64;
        const bf16x8 qf0 = __builtin_nontemporal_load((const GAS bf16x8*)(qp + 8 * fq)), qf1 = __builtin_nontemporal_load((const GAS bf16x8*)(qp + 32 + 8 * fq));
        __syncthreads();
        const int t0 = w < 6 ? w : 6;
        f32x4 st[10];
#pragma unroll
        for (int x = 0; x < 10; ++x) {
            const LAS bf16_t* kp = Ks + (16 * ((t0 + x + rot16) & 15) + fr) * 72 + 8 * fq;
            const bf16x8 a0 = *(const LAS bf16x8*)kp, a1 = *(const LAS bf16x8*)(kp + 32);
            f32x4 acc = {0.f, 0.f, 0.f, 0.f};
            acc = __builtin_amdgcn_mfma_f32_16x16x32_bf16(a0, qf0, acc, 0, 0, 0);
            acc = __builtin_amdgcn_mfma_f32_16x16x32_bf16(a1, qf1, acc, 0, 0, 0);
            st[x] = acc;
        }
        float mx = -INFINITY;
#pragma unroll
        for (int x = 0; x < 10; ++x)
#pragma unroll
            for (int i = 0; i < 4; ++i) {
                const int kj = 16 * (t0 + x) + 4 * fq + i, dist = qi + 128 - kj;
                const bool valid = (dist >= 0) && (dist <= 128) && (n > 0 || kj >= 128);
                const float s = valid ? st[x][i] : -INFINITY; st[x][i] = s; mx = fmaxf(mx, s);
            }
        mx = fmaxf(mx, lane_xor<16>(mx)); mx = max_xor32(mx);
        float sum = 0.f;
#pragma unroll
        for (int x = 0; x < 10; ++x)
#pragma unroll
            for (int i = 0; i < 4; ++i) { const float p = __builtin_amdgcn_exp2f((st[x][i] - mx) * 1.4426950408889634f); st[x][i] = p; sum += p; }
        sum += lane_xor<16>(sum); sum = sum_xor32(sum);
        f32x4 o[4];
#pragma unroll
        for (int dt = 0; dt < 4; ++dt) o[dt] = (f32x4){0.f, 0.f, 0.f, 0.f};
#pragma unroll
        for (int y = 0; y < 5; ++y) {
            u32x4 pw; pw.x = cvt_pk_bf16(st[2 * y][0], st[2 * y][1]); pw.y = cvt_pk_bf16(st[2 * y][2], st[2 * y][3]);
            pw.z = cvt_pk_bf16(st[2 * y + 1][0], st[2 * y + 1][1]); pw.w = cvt_pk_bf16(st[2 * y + 1][2], st[2 * y + 1][3]);
            const bf16x8 pb = __builtin_bit_cast(bf16x8, pw);
            const int ka = 16 * ((t0 + 2 * y + rot16) & 15) + 4 * fq, kb = 16 * ((t0 + 2 * y + 1 + rot16) & 15) + 4 * fq;
#pragma unroll
            for (int dt = 0; dt < 4; ++dt) {
                const LAS bf16_t* vr = Vt + (16 * dt + fr) * 264; const int sw = ((2 * dt + (fr >> 3)) & 7) << 3;
                const s16x4 va = *(const LAS s16x4*)(vr + (ka ^ sw)), vb = *(const LAS s16x4*)(vr + (kb ^ sw));
                const bf16x8 a = {va[0], va[1], va[2], va[3], vb[0], vb[1], vb[2], vb[3]};
                o[dt] = __builtin_amdgcn_mfma_f32_16x16x32_bf16(a, pb, o[dt], 0, 0, 0);
            }
        }
        const float inv = 1.0f / sum;
        bf16_t* qst = dry ? (bf16_t*)(C.ws + WS_PP) + tid * 64 : qp;
#pragma unroll
        for (int dt = 0; dt < 4; ++dt) {
            u32x2 wv; wv.x = cvt_pk_bf16(o[dt][0] * inv, o[dt][1] * inv); wv.y = cvt_pk_bf16(o[dt][2] * inv, o[dt][3] * inv);
            *(GAS u32x2*)(qst + 16 * dt + 4 * fq) = wv;
        }
        if (fq == 0) *(GAS float*)(dry ? (float*)(C.ws + WS_PP) + 1048576 + tid : lse + qrow * 12 + head) = mx + __builtin_amdgcn_logf(sum) * 0.6931471805599453f;
        __syncthreads();
    }
}

DI void phase_mix(const Ctx& C, bf16_t* Z, const float* lse_, int L, bool dry) {
    const GAS float* lse = (const GAS float*)lse_;
    bf16_t* dummy = (bf16_t*)(C.ws + WS_PP) + C.tid * 64;
    const int gt = C.bid * 512 + C.tid, ngt = C.gsz * 512;
    for (int base = gt; base < MTOK * 96; base += 12 * ngt) {
        u32x4 v[12]; float l0[12], l1[12], l2[12];
#pragma unroll
        for (int k = 0; k < 12; ++k) {
            const int idx = base + k * ngt;
            if (idx < MTOK * 96) {
                const int lrow = idx / 96, rem = idx - lrow * 96, head = rem >> 3, ch = rem & 7, slot = head & 3;
                l0[k] = lse[(size_t)lrow * 12 + slot]; l1[k] = lse[(size_t)lrow * 12 + 4 + slot]; l2[k] = lse[(size_t)lrow * 12 + 8 + slot];
                v[k] = __builtin_nontemporal_load((const GAS u32x4*)(Z + (size_t)lrow * ZW + head * 64 + ch * 8));
            }
        }
#pragma unroll
        for (int k = 0; k < 12; ++k) {
            const int idx = base + k * ngt;
            if (idx < MTOK * 96) {
                const int lrow = idx / 96, rem = idx - lrow * 96, head = rem >> 3, ch = rem & 7, g = head >> 2;
                const float mx = fmaxf(l0[k], fmaxf(l1[k], l2[k]));
                const float e0 = __builtin_amdgcn_exp2f((l0[k] - mx) * 1.4426950408889634f), e1 = __builtin_amdgcn_exp2f((l1[k] - mx) * 1.4426950408889634f), e2 = __builtin_amdgcn_exp2f((l2[k] - mx) * 1.4426950408889634f);
                const float al = (g == 0 ? e0 : (g == 1 ? e1 : e2)) / (e0 + e1 + e2);
                bf16_t* p = Z + (size_t)lrow * ZW + head * 64 + ch * 8;
                u32x4 w;
                w.x = cvt_pk_bf16(bf_lo(v[k].x) * al, bf_hi(v[k].x) * al); w.y = cvt_pk_bf16(bf_lo(v[k].y) * al, bf_hi(v[k].y) * al);
                w.z = cvt_pk_bf16(bf_lo(v[k].z) * al, bf_hi(v[k].z) * al); w.w = cvt_pk_bf16(bf_lo(v[k].w) * al, bf_hi(v[k].w) * al);
                *(GAS u32x4*)(dry ? dummy : p) = w;
            }
        }
    }
    const float* cw = (const float*)argp(C.lds, 5) + (size_t)L * 3 * 512;
    for (int base = gt; base < MTOK * 64; base += 4 * ngt) {
        u32x4 xv[4][3], cv[4][3], bv[4];
#pragma unroll
        for (int k = 0; k < 4; ++k) {
            const int idx = base + k * ngt; const int lrow = idx >> 6, c0 = (idx & 63) * 8, t = lrow & (SEQ - 1);
#pragma unroll
            for (int jj = 0; jj < 3; ++jj) {
                const int back = 2 - jj; xv[k][jj] = (u32x4){0u, 0u, 0u, 0u}; cv[k][jj] = (u32x4){0u, 0u, 0u, 0u};
                if (idx < MTOK * 64 && t >= back) { const bf16_t* zr = Z + (size_t)(lrow - back) * ZW + c0; xv[k][jj] = *(const GAS u32x4*)(zr + CX); cv[k][jj] = *(const GAS u32x4*)(zr + CC); }
            }
            bv[k] = (u32x4){0u, 0u, 0u, 0u};
            if (idx < MTOK * 64) bv[k] = __builtin_nontemporal_load((const GAS u32x4*)(Z + (size_t)lrow * ZW + CB + c0));
        }
#pragma unroll
        for (int k = 0; k < 4; ++k) {
            const int idx = base + k * ngt; const int lrow = idx >> 6, c0 = (idx & 63) * 8;
            if (idx < MTOK * 64) {
                float accv[8];
#pragma unroll
                for (int e = 0; e < 8; ++e) accv[e] = 0.f;
#pragma unroll
                for (int jj = 0; jj < 3; ++jj) {
                    const f32x4 w0 = *(const GAS f32x4*)(cw + jj * 512 + c0), w1 = *(const GAS f32x4*)(cw + jj * 512 + c0 + 4);
                    const u32x4 x_ = xv[k][jj], c_ = cv[k][jj];
                    accv[0] += w0.x * bf_lo(x_.x) * bf_lo(c_.x); accv[1] += w0.y * bf_hi(x_.x) * bf_hi(c_.x);
                    accv[2] += w0.z * bf_lo(x_.y) * bf_lo(c_.y); accv[3] += w0.w * bf_hi(x_.y) * bf_hi(c_.y);
                    accv[4] += w1.x * bf_lo(x_.z) * bf_lo(c_.z); accv[5] += w1.y * bf_hi(x_.z) * bf_hi(c_.z);
                    accv[6] += w1.z * bf_lo(x_.w) * bf_lo(c_.w); accv[7] += w1.w * bf_hi(x_.w) * bf_hi(c_.w);
                }
                bf16_t* bp = Z + (size_t)lrow * ZW + CB + c0;
                u32x4 w;
                w.x = cvt_pk_bf16(bf_lo(bv[k].x) * accv[0], bf_hi(bv[k].x) * accv[1]); w.y = cvt_pk_bf16(bf_lo(bv[k].y) * accv[2], bf_hi(bv[k].y) * accv[3]);
                w.z = cvt_pk_bf16(bf_lo(bv[k].z) * accv[4], bf_hi(bv[k].z) * accv[5]); w.w = cvt_pk_bf16(bf_lo(bv[k].w) * accv[6], bf_hi(bv[k].w) * accv[7]);
                *(GAS u32x4*)(dry ? dummy : bp) = w;
            }
        }
    }
    const int lane = C.lane, w = C.wave, fr = lane & 15, fq = lane >> 4, tid = C.tid;
    LAS bf16_t* Vt2 = (LAS bf16_t*)C.lds;
    LAS float* stat = (LAS float*)(C.lds + 34816);
    const bf16_t* sgw = (const bf16_t*)(C.ws + WS_SGW);
    const float* ln_g = (const float*)argp(C.lds, 6) + L * 512; const float* ln_b = (const float*)argp(C.lds, 7) + L * 512; const GAS float* sg_b = (const GAS float*)argp(C.lds, 9) + L * 512;
    for (int ck = C.bid; ck < MTOK / 128; ck += C.gsz) {
        const int row0 = ck * 128;
        {
            const int tk = tid >> 2, q4 = tid & 3;
            const bf16_t* vr = Z + (size_t)(row0 + tk) * ZW + CVV + q4 * 128;
            float s1 = 0.f, s2 = 0.f;
#pragma unroll
            for (int i = 0; i < 16; ++i) {
                const u32x4 raw = *(const GAS u32x4*)(vr + i * 8);
                const float x0 = bf_lo(raw.x), x1 = bf_hi(raw.x), x2 = bf_lo(raw.y), x3 = bf_hi(raw.y), x4 = bf_lo(raw.z), x5 = bf_hi(raw.z), x6 = bf_lo(raw.w), x7 = bf_hi(raw.w);
                s1 += ((x0 + x1) + (x2 + x3)) + ((x4 + x5) + (x6 + x7));
                s2 += ((x0 * x0 + x1 * x1) + (x2 * x2 + x3 * x3)) + ((x4 * x4 + x5 * x5) + (x6 * x6 + x7 * x7));
            }
            s1 += lane_xor<1>(s1); s1 += lane_xor<2>(s1); s2 += lane_xor<1>(s2); s2 += lane_xor<2>(s2);
            const float mean = s1 * (1.0f / 512.0f), var = fmaxf(s2 * (1.0f / 512.0f) - mean * mean, 0.f);
            if (q4 == 0) { stat[tk * 2] = mean; stat[tk * 2 + 1] = 1.0f / sqrtf(var + 1e-5f); }
        }
        __syncthreads();
        u32x4 raw[4];
#pragma unroll
        for (int cc = 0; cc < 4; ++cc) { const int c = tid + cc * 512, tk = c >> 4, ch = c & 15; raw[cc] = *(const GAS u32x4*)(Z + (size_t)(row0 + tk) * ZW + CVV + ch * 8); }
        for (int g = 0; g < 4; ++g) {
        const int tkE = 16 * w + fr;
        bf16_t* up = Z + (size_t)(row0 + tkE) * ZW + CU + g * 128 + 4 * fq;
        u32x2 uq[8];
#pragma unroll
        for (int ct = 0; ct < 8; ++ct) uq[ct] = __builtin_nontemporal_load((const GAS u32x2*)(up + 16 * ct));
        const float bias = sg_b[g * 128 + tkE];
#pragma unroll
        for (int cc = 0; cc < 4; ++cc) {
            const int c = tid + cc * 512, tk = c >> 4, ch = c & 15, c0 = g * 128 + ch * 8;
            const u32x4 rw = raw[cc];
            const float mean = stat[tk * 2], rstd = stat[tk * 2 + 1];
            const f32x4 g0 = *(const GAS f32x4*)(ln_g + c0), g1 = *(const GAS f32x4*)(ln_g + c0 + 4), b0 = *(const GAS f32x4*)(ln_b + c0), b1 = *(const GAS f32x4*)(ln_b + c0 + 4);
            LAS bf16_t* vp = Vt2 + (ch * 8) * 136 + (tk ^ (ch << 3));
            const unsigned p0 = cvt_pk_bf16((bf_lo(rw.x) - mean) * rstd * g0.x + b0.x, (bf_hi(rw.x) - mean) * rstd * g0.y + b0.y);
            const unsigned p1 = cvt_pk_bf16((bf_lo(rw.y) - mean) * rstd * g0.z + b0.z, (bf_hi(rw.y) - mean) * rstd * g0.w + b0.w);
            const unsigned p2 = cvt_pk_bf16((bf_lo(rw.z) - mean) * rstd * g1.x + b1.x, (bf_hi(rw.z) - mean) * rstd * g1.y + b1.y);
            const unsigned p3 = cvt_pk_bf16((bf_lo(rw.w) - mean) * rstd * g1.z + b1.z, (bf_hi(rw.w) - mean) * rstd * g1.w + b1.w);
            vp[0 * 136] = (bf16_t)(p0 & 0xffffu); vp[1 * 136] = (bf16_t)(p0 >> 16); vp[2 * 136] = (bf16_t)(p1 & 0xffffu); vp[3 * 136] = (bf16_t)(p1 >> 16);
            vp[4 * 136] = (bf16_t)(p2 & 0xffffu); vp[5 * 136] = (bf16_t)(p2 >> 16); vp[6 * 136] = (bf16_t)(p3 & 0xffffu); vp[7 * 136] = (bf16_t)(p3 >> 16);
        }
        __syncthreads();
        if (g < 3) {
#pragma unroll
            for (int cc = 0; cc < 4; ++cc) { const int c = tid + cc * 512, tk = c >> 4, ch = c & 15; raw[cc] = *(const GAS u32x4*)(Z + (size_t)(row0 + tk) * ZW + CVV + (g + 1) * 128 + ch * 8); }
        }
        f32x4 acc[8];
#pragma unroll
        for (int ct = 0; ct < 8; ++ct) acc[ct] = (f32x4){0.f, 0.f, 0.f, 0.f};
        const bf16_t* wrow = sgw + (size_t)(g * 128 + 16 * w + fr) * 128 + 8 * fq;
        const int nks = (w >> 1) + 1;
        for (int ks = 0; ks < nks; ++ks) {
            const bf16x8 bw = *(const GAS bf16x8*)(wrow + 32 * ks);
#pragma unroll
            for (int ct = 0; ct < 8; ++ct) {
                const bf16x8 av = *(const LAS bf16x8*)(Vt2 + (16 * ct + fr) * 136 + ((32 * ks + 8 * fq) ^ (((2 * ct + (fr >> 3)) & 15) << 3)));
                acc[ct] = __builtin_amdgcn_mfma_f32_16x16x32_bf16(av, bw, acc[ct], 0, 0, 0);
            }
        }
#pragma unroll
        for (int ct = 0; ct < 8; ++ct) {
            const u32x2 uv = uq[ct]; u32x2 wv;
            wv.x = cvt_pk_bf16(bf_lo(uv.x) * (acc[ct][0] + bias), bf_hi(uv.x) * (acc[ct][1] + bias));
            wv.y = cvt_pk_bf16(bf_lo(uv.y) * (acc[ct][2] + bias), bf_hi(uv.y) * (acc[ct][3] + bias));
            *(GAS u32x2*)(dry ? dummy + 16 * ct : up + 16 * ct) = wv;
        }
        __syncthreads();
        }
    }
}

DI void phase_final(const Ctx& C) {
    GAS float* out = (GAS float*)argp(C.lds, 21); const GAS bf16_t* hb = (const GAS bf16_t*)(C.ws + WS_HBB); const GAS float* ssqC = (const GAS float*)(C.ws + WS_SSQC); const GAS float* gf = (const GAS float*)argp(C.lds, 20);
    f32x4 g[4];
#pragma unroll
    for (int j = 0; j < 4; ++j) g[j] = ((const GAS f32x4*)gf + C.lane)[64 * j];
    for (int m0 = C.gw; m0 < MTOK; m0 += 8 * C.ngw) {
        u32x2 hv[8][4]; float sq[8];
#pragma unroll
        for (int k = 0; k < 8; ++k) { const int m = m0 + k * C.ngw; sq[k] = 0.f; if (m < MTOK) {
            sq[k] = (C.lane < 16) ? ssqC[(size_t)m * 16 + C.lane] : 0.f;
            const GAS u32x2* hr = (const GAS u32x2*)(hb + (size_t)m * DM) + C.lane;
#pragma unroll
            for (int j = 0; j < 4; ++j) hv[k][j] = __builtin_nontemporal_load(hr + 64 * j); } }
#pragma unroll
        for (int k = 0; k < 8; ++k) { const int m = m0 + k * C.ngw; if (m < MTOK) {
            const float rs = 1.0f / sqrtf(wave_sum(sq[k]) * (1.0f / 1024.0f) + 1e-6f);
            GAS f32x4* orow = (GAS f32x4*)(out + (size_t)m * DM) + C.lane;
#pragma unroll
            for (int j = 0; j < 4; ++j) { const u32x2 h2 = hv[k][j];
                f32x4 v; v.x = bf_lo(h2.x) * rs * g[j].x; v.y = bf_hi(h2.x) * rs * g[j].y; v.z = bf_lo(h2.y) * rs * g[j].z; v.w = bf_hi(h2.y) * rs * g[j].w; orow[64 * j] = v; } } }
    }
}

#define XB_TMO      128
#define XB_XCNT(j)  (256  + 64 * (j))
#define XB_XSUB(j)  (1280 + 64 * (j))
#define XB_XGEN(j)  (2304 + 64 * (j))
#define XB_TOP      3328
#define XB_TOPGEN   3392
#define XCD_BAR_WORDS 3456
#define XB_SPIN_CAP (1u << 18)

__device__ __forceinline__ unsigned xb_ld(unsigned* p)              { return __hip_atomic_load(p, __ATOMIC_RELAXED, __HIP_MEMORY_SCOPE_AGENT); }
__device__ __forceinline__ unsigned xb_add(unsigned* p, unsigned v) { return __hip_atomic_fetch_add(p, v, __ATOMIC_RELAXED, __HIP_MEMORY_SCOPE_AGENT); }
__device__ __forceinline__ unsigned xb_xcc_id() { return (unsigned)__builtin_amdgcn_s_getreg((3 << 11) | 20) & 0xFu; }
#define XB_SPIN(cond, bar) do { unsigned _sp = 0; while (cond) { __builtin_amdgcn_s_sleep(1); \
    if ((++_sp & 255u) == 0u) { if (xb_ld(&(bar)[XB_TMO])) break; if (_sp > XB_SPIN_CAP) { atomicAdd(&(bar)[XB_TMO], 1u); break; } } } } while (0)

struct XcdBarrier {
    unsigned* bar; unsigned x;
    volatile LAS unsigned* st;
};

__device__ __forceinline__ XcdBarrier xcd_barrier_post(unsigned* bar, volatile LAS unsigned* st) {
    XcdBarrier b; b.bar = bar; b.x = xb_xcc_id(); b.st = st;
    if (threadIdx.x == 0) (void)xb_add(&bar[XB_XCNT(b.x)], 1u);
    return b;
}
__device__ __forceinline__ void xcd_barrier_complete(unsigned* bar, unsigned x, unsigned& nloc, unsigned& nx) {
    const unsigned G = gridDim.x * gridDim.y * gridDim.z;
    unsigned sum, cnt, mine, sp = 0u;
    for (;;) {
        sum = 0u; cnt = 0u; mine = 0u;
#pragma unroll
        for (unsigned j = 0; j < 16; ++j) { const unsigned c = xb_ld(&bar[XB_XCNT(j)]); sum += c; cnt += (c > 0u) ? 1u : 0u; mine = (j == x) ? c : mine; }
        if (sum == G) break;
        __builtin_amdgcn_s_sleep(1);
        if ((++sp & 255u) == 0u) { if (xb_ld(&bar[XB_TMO])) break; if (sp > XB_SPIN_CAP) { atomicAdd(&bar[XB_TMO], 1u); break; } }
    }
    nloc = mine > 0u ? mine : 1u; nx = cnt > 0u ? cnt : 1u;
}

__device__ __forceinline__ void xcd_barrier(const XcdBarrier& b) {
    asm volatile("s_waitcnt vmcnt(0)" ::: "memory");
    __syncthreads();
    if (threadIdx.x == 0) {
        unsigned* bar = b.bar;
        __builtin_amdgcn_s_waitcnt(0);
        unsigned nloc = b.st[0], nx = b.st[1];
        if (nloc == 0u) { xcd_barrier_complete(bar, b.x, nloc, nx); b.st[0] = nloc; b.st[1] = nx; }
        const unsigned old = xb_add(&bar[XB_XSUB(b.x)], 1u);
        const unsigned gen = old / nloc;
        if (old + 1u == (gen + 1u) * nloc) {
            __builtin_amdgcn_fence(__ATOMIC_RELEASE, "agent");
            asm volatile("s_waitcnt vmcnt(0)" ::: "memory");
            const unsigned og = xb_add(&bar[XB_TOP], 1u);
            const unsigned tg = og / nx;
            if (og + 1u == (tg + 1u) * nx) xb_add(&bar[XB_TOPGEN], 1u);
            else XB_SPIN(xb_ld(&bar[XB_TOPGEN]) == tg, bar);
            __builtin_amdgcn_fence(__ATOMIC_ACQUIRE, "agent");
            xb_add(&bar[XB_XGEN(b.x)], 1u);
            asm volatile("s_waitcnt vmcnt(0)" ::: "memory");
        } else {
            XB_SPIN(xb_ld(&bar[XB_XGEN(b.x)]) == gen, bar);
            __builtin_amdgcn_fence(__ATOMIC_ACQUIRE, "agent");
            asm volatile("s_waitcnt vmcnt(0)" ::: "memory");
        }
    }
    __syncthreads();
}

__global__ void __launch_bounds__(512) fwd_megakernel(Args args) {
    extern __shared__ __attribute__((aligned(16))) unsigned char lds_raw[];
    cg::grid_group grid = cg::this_grid();
    const int wave_s = __builtin_amdgcn_readfirstlane((int)threadIdx.x >> 6);
    {
        LAS unsigned long long* tb = (LAS unsigned long long*)((LAS unsigned char*)lds_raw + ARG_OFF);
        if (threadIdx.x < 21) tb[threadIdx.x] = (unsigned long long)args.in[threadIdx.x];
        if (threadIdx.x == 21) tb[21] = (unsigned long long)args.out;
        if (threadIdx.x == 22) tb[22] = (unsigned long long)args.ws;
        if (threadIdx.x >= 32 && threadIdx.x < 40) ((LAS float*)(tb + 23))[threadIdx.x - 32] = args.invf[threadIdx.x - 32];
        if (threadIdx.x == 64) { ((LAS unsigned*)((LAS unsigned char*)lds_raw + ARG_OFF + 256))[0] = 0u; ((LAS unsigned*)((LAS unsigned char*)lds_raw + ARG_OFF + 256))[1] = 0u; }
        __syncthreads();
    }
    (void)xcd_barrier_post((unsigned*)(args.ws + WS_BAR), (volatile LAS unsigned*)((LAS unsigned char*)lds_raw + ARG_OFF + 256));
    int rep = 0;
    for (int ph = args.ph_lo; ph < args.ph_hi;) {
        int want = 1;
        const int tid_ = wave_s * 64 + lane_id_opaque();
        int bid_ = blockIdx.x, gsz_ = gridDim.x; asm volatile("" : "+s"(bid_), "+s"(gsz_));
        Ctx C; C.lds = (LAS unsigned char*)lds_raw; C.ws = nullptr; C.tid = tid_; C.lane = C.tid & 63; C.wave = wave_s;
        C.bid = bid_; C.gsz = gsz_;
        unsigned char* ws = (unsigned char*)argp(C.lds, 22); C.ws = ws;
        C.gw = C.bid * 8 + C.wave; C.ngw = C.gsz * 8;
        bf16_t* Z = (bf16_t*)(ws + WS_BIG); bf16_t* U = (bf16_t*)(ws + WS_BIG); bf16_t* PP = (bf16_t*)(ws + WS_PP);
        bf16_t* hbA = (bf16_t*)(ws + WS_HBA); bf16_t* hbB = (bf16_t*)(ws + WS_HBB);
        float* ssqA = (float*)(ws + WS_SSQA); float* ssqB = (float*)(ws + WS_SSQB); float* ssqC = (float*)(ws + WS_SSQC);
        float* lse = (float*)(ws + WS_LSE); float* rope = (float*)(ws + WS_ROPE);
        int njobs = 0, jtype = 0, L = 0;
        if (ph == 0) phase_prologue(C);
        else if (ph == NPHASE - 1) phase_final(C);
        else {
            L = (ph - 1) / 9; const int s = (ph - 1) % 9;
            if (s == 0) { phase_convert(C, L); want = 1 + PROBE_CVT; }
            else if (s == 1) { njobs = 1; jtype = 0; }
            else if (s == 2) { phase_attn(C, Z, lse, false); want = 1 + PROBE_ATTN; }
            else if (s == 3) { phase_mix(C, Z, lse, L, false); want = 1 + PROBE_MIX; }
            else if (s == 4) { njobs = 6; jtype = 1; }
            else if (s == 5) { njobs = 1; jtype = 2; }
            else if (s == 6) { njobs = 1; jtype = 3; }
            else if (s == 7) { njobs = 2; jtype = 4; }
            else { njobs = 1; jtype = 6; }
        }
        for (int ji = 0; ji < njobs; ++ji) {
            const int jt = jtype == 1 ? ((ji & 1) ? 1 : 0) : (jtype + ((jtype == 4) ? ji : 0));
            const bool gate_job = (jtype == 1);
            if (jt == 0) {
                const int b = ji >> 1;
                EpiIn E{gate_job ? (bf16_t*)(ws + WS_G) : Z, ssqC, rope, (bf16_t*)nullptr, gate_job ? DM : ZW, gate_job ? 4 : -1};
                want = gate_job ? 1 + PROBE_GATE : 1 + PROBE_IN + PROBE_INDRY;
                run_gemm(C.lds, C.bid, C.gsz, C.wave, hbB, DM, (const bf16_t*)(ws + WS_WIN) + (gate_job ? (size_t)(ZW + b * DM) * DM : 0), MTOK, gate_job ? DM : ZW, DM, E);
            } else if (jt == 1) {
                const int b = ji >> 1;
                const int ca = b == 0 ? CQ : (b == 1 ? CB : CU); const int kk = b == 0 ? 768 : 512;
                const bf16_t* bt = (const bf16_t*)(ws + (b == 0 ? WS_WBA : (b == 1 ? WS_WBB : WS_WBC)));
                EpiGate E{(const bf16_t*)(ws + WS_G), Z + CK, b > 0, (bf16_t*)nullptr}; want = 1 + PROBE_GATE; run_gemm(C.lds, C.bid, C.gsz, C.wave, Z + ca, ZW, bt, MTOK, DM, kk, E);
            } else if (jt == 2 || jt == 4) {
                const bool mix = (jt == 2);
                EpiRes E{mix ? hbB : hbA, hbA, mix ? ssqA : ssqB, (float*)nullptr};
                want = 1 + (mix ? PROBE_RESMIX : PROBE_DOWN);
                run_gemm(C.lds, C.bid, C.gsz, C.wave, mix ? Z + CK : U, mix ? ZW : UP, (const bf16_t*)(ws + (mix ? WS_WOUT3 : WS_WDOWN)), MTOK, DM, mix ? DM : DFF, E, mix ? DM : UP);
            } else if (jt == 3) { EpiUp E{U, ssqA}; want = 1 + PROBE_UP; run_gemm(C.lds, C.bid, C.gsz, C.wave, hbA, DM, (const bf16_t*)(ws + WS_WUP), MTOK, DFF, DM, E); }
            else if (jt == 5) { EpiPlain E{PP, DM}; run_gemm(C.lds, C.bid, C.gsz, C.wave, (const bf16_t*)(ws + WS_PBF), PLE, (const bf16_t*)(ws + WS_WPE), MTOK, DM, PLE, E); }
            else { EpiPle E{hbA, PP, ssqB, hbB, ssqC, (float*)nullptr}; want = 1 + PROBE_PLE; run_gemm(C.lds, C.bid, C.gsz, C.wave, hbA, DM, (const bf16_t*)(ws + WS_WPG), MTOK, DM, DM, E); }
        }
        if (++rep >= want) { rep = 0; ++ph; }
        if (ph < args.ph_hi) {
            if (ph == 1 && rep == 0) grid.sync();
            else {
                XcdBarrier xbar; xbar.bar = (unsigned*)(ws + WS_BAR); xbar.x = xb_xcc_id(); xbar.st = (volatile LAS unsigned*)(C.lds + ARG_OFF + 256);
                xcd_barrier(xbar); if (PROBE_SYNC) xcd_barrier(xbar);
            }
        }
    }
}

extern "C" void kernel_launch(void* const* d_in, const int* in_sizes, int n_in, void* d_out, int out_size, void* d_ws, size_t ws_size, hipStream_t stream) {
    static int grid = 0;
    if (grid == 0) {
        if (n_in != 21 || out_size != MTOK * DM || ws_size < WS_END) { fprintf(stderr, "kernel_launch: unexpected sizes (n_in %d out %d ws %zu)\n", n_in, out_size, ws_size); grid = -1; return; }
        int dev = 0, cus = 0, per_cu = 0;
        (void)hipGetDevice(&dev); (void)hipDeviceGetAttribute(&cus, hipDeviceAttributeMultiprocessorCount, dev);
        (void)hipFuncSetAttribute((const void*)fwd_megakernel, hipFuncAttributeMaxDynamicSharedMemorySize, LDS_BYTES);
        (void)hipOccupancyMaxActiveBlocksPerMultiprocessor(&per_cu, (const void*)fwd_megakernel, 512, LDS_BYTES);
        (void)hipGetLastError();
        if (per_cu < 1) per_cu = 1;
        grid = cus;
        if (grid <= 0) grid = 256;
    }
    if (grid < 0) return;
    (void)hipMemsetAsync((char*)d_ws + WS_BAR, 0, 16384, stream);
    Args a{};
    for (int i = 0; i < 21; ++i) a.in[i] = d_in[i];
    a.out = (float*)d_out; a.ws = (unsigned char*)d_ws;
    for (int j = 0; j < 8; ++j) a.invf[j] = (float)pow(500000.0, -(double)(2 * j) / 16.0);
#if MK_PER_PHASE_LAUNCH
    for (int ph = 0; ph < NPHASE; ++ph) { a.ph_lo = ph; a.ph_hi = ph + 1; hipLaunchKernelGGL(fwd_megakernel, dim3(grid), dim3(512), LDS_BYTES, stream, a); }
#else
    a.ph_lo = 0; a.ph_hi = NPHASE;
    void* kargs[] = {&a};
    hipError_t e = hipLaunchCooperativeKernel((const void*)fwd_megakernel, dim3(grid), dim3(512), kargs, LDS_BYTES, stream);
    if (e != hipSuccess) fprintf(stderr, "cooperative launch failed: %s (grid %d)\n", hipGetErrorString(e), grid);
#endif
}
```
